# Optimizing an MI355X kernel written in HIP

```python
import math
import jax, jax.numpy as jnp
from jax import lax
import numpy as np

D_MODEL = 2048
BATCH = 1
SEQ = 8192
DEPTH = 1

MIX_WIDTH = D_MODEL
HGRN_WIDTH = MIX_WIDTH // 2
HGRN_DK = 128
HGRN_HEADS = HGRN_WIDTH // HGRN_DK
HGRN_DV = HGRN_WIDTH // HGRN_HEADS
FOURIER_WIDTH = MIX_WIDTH - HGRN_WIDTH
FOURIER_GROUPS = 4
FOURIER_GDIM = FOURIER_WIDTH // FOURIER_GROUPS
CHUNK = 64
D_FF = int(math.ceil((8 * D_MODEL / 3) / 256) * 256)
PROJ_WIDTH = 5 * HGRN_WIDTH + FOURIER_WIDTH
DEEPNORM_ALPHA = (2.0 * DEPTH) ** 0.25
DEEPNORM_BETA = (8.0 * DEPTH) ** -0.25
LN_EPS = 1e-5
RMS_EPS = 1e-6

kernel_name = "hgrn2_fourier_hybrid_deepnorm_encoder"


def _layernorm(x, g, b):
    xf = x.astype(jnp.float32)
    mu = jnp.mean(xf, axis=-1, keepdims=True)
    var = jnp.mean(jnp.square(xf - mu), axis=-1, keepdims=True)
    y = (xf - mu) * lax.rsqrt(var + LN_EPS) * g.astype(jnp.float32) + b.astype(jnp.float32)
    return y.astype(x.dtype)


def _chunk_recurrence(q, k, v, logf):
    B, T, H, K = q.shape
    V = v.shape[-1]
    N = T // CHUNK
    qc = q.reshape(B, N, CHUNK, H, K)
    kc = k.reshape(B, N, CHUNK, H, K)
    vc = v.reshape(B, N, CHUNK, H, V)
    bcum = jnp.cumsum(logf.reshape(B, N, CHUNK, H, K), axis=2)
    b_last = bcum[:, :, -1:]
    q_dec = qc * jnp.exp(bcum)
    k_inv = kc * jnp.exp(-bcum)
    k_end = kc * jnp.exp(b_last - bcum)
    scores = jnp.einsum('bnthk,bnshk->bnhts', q_dec, k_inv)
    tri = jnp.tril(jnp.ones((CHUNK, CHUNK), dtype=bool))
    scores = jnp.where(tri, scores, 0.0)
    o_intra = jnp.einsum('bnhts,bnshv->bnthv', scores, vc)
    d_state = jnp.einsum('bnshk,bnshv->bnhkv', k_end, vc)
    decay = jnp.exp(b_last[:, :, 0])

    def step(S, inp):
        d, ds = inp
        return d[..., None] * S + ds, S

    S0 = jnp.zeros((B, H, K, V), dtype=q.dtype)
    _, S_prev = lax.scan(step, S0, (jnp.moveaxis(decay, 1, 0), jnp.moveaxis(d_state, 1, 0)))
    S_prev = jnp.moveaxis(S_prev, 0, 1)
    o_inter = jnp.einsum('bnthk,bnhkv->bnthv', q_dec, S_prev)
    return (o_intra + o_inter).reshape(B, T, H, V)


def _forget(z, lb):
    f = lb + (1.0 - lb) * jax.nn.sigmoid(z.astype(jnp.float32))
    return jnp.log(f), 1.0 - f


def _hgrn2_group(q_raw, i_raw, zf, zb, g_raw, lb_f, lb_b, g_norm):
    B, T, _ = q_raw.shape
    shp_k = (B, T, HGRN_HEADS, HGRN_DK)
    shp_v = (B, T, HGRN_HEADS, HGRN_DV)
    q = jax.nn.silu(q_raw.astype(jnp.float32)).reshape(shp_k)
    v = i_raw.astype(jnp.float32).reshape(shp_v)
    logf_f, k_f = _forget(zf, lb_f)
    logf_b, k_b = _forget(zb, lb_b)
    o_fwd = _chunk_recurrence(q, k_f.reshape(shp_k), v, logf_f.reshape(shp_k))
    flip = lambda a: jnp.flip(a, axis=1)
    o_bwd = flip(_chunk_recurrence(flip(q), flip(k_b.reshape(shp_k)), flip(v), flip(logf_b.reshape(shp_k))))
    o = o_fwd + o_bwd
    o = o * lax.rsqrt(jnp.mean(jnp.square(o), axis=-1, keepdims=True) + RMS_EPS) * g_norm.astype(jnp.float32)
    o = o * jax.nn.silu(g_raw.astype(jnp.float32)).reshape(shp_v)
    return o.reshape(B, T, HGRN_WIDTH).astype(q_raw.dtype)


def _fourier_group(u):
    B, T, _ = u.shape
    ug = u.astype(jnp.float32).reshape(B, T, FOURIER_GROUPS, FOURIER_GDIM)
    y = jnp.real(jnp.fft.fft2(ug, axes=(1, 3), norm='ortho'))
    return y.reshape(B, T, FOURIER_WIDTH).astype(u.dtype)


def setup_inputs(seed: int = 0) -> dict:
    key = jax.random.key(seed)
    ks = jax.random.split(key, 16)
    f32 = jnp.float32
    x = jax.random.normal(ks[0], (BATCH, SEQ, D_MODEL), f32)
    ln_emb_g = 1.0 + 0.02 * jax.random.normal(ks[1], (D_MODEL,), f32)
    ln_emb_b = 0.02 * jax.random.normal(ks[2], (D_MODEL,), f32)
    w_in = jax.random.normal(ks[3], (DEPTH, D_MODEL, PROJ_WIDTH), f32) * D_MODEL ** -0.5
    lb_fwd_logits = 0.5 * jax.random.normal(ks[4], (DEPTH + 1, HGRN_WIDTH), f32)
    lb_bwd_logits = 0.5 * jax.random.normal(ks[5], (DEPTH + 1, HGRN_WIDTH), f32)
    g_norm = 1.0 + 0.02 * jax.random.normal(ks[6], (DEPTH, HGRN_DV), f32)
    w_out = jax.random.normal(ks[7], (DEPTH, MIX_WIDTH, D_MODEL), f32) * (MIX_WIDTH ** -0.5 * DEEPNORM_BETA)
    ln1_g = 1.0 + 0.02 * jax.random.normal(ks[8], (DEPTH, D_MODEL), f32)
    ln1_b = 0.02 * jax.random.normal(ks[9], (DEPTH, D_MODEL), f32)
    w_gate = jax.random.normal(ks[10], (DEPTH, D_MODEL, D_FF), f32) * D_MODEL ** -0.5
    w_up = jax.random.normal(ks[11], (DEPTH, D_MODEL, D_FF), f32) * D_MODEL ** -0.5
    w_down = jax.random.normal(ks[12], (DEPTH, D_FF, D_MODEL), f32) * (D_FF ** -0.5 * DEEPNORM_BETA)
    ln2_g = 1.0 + 0.02 * jax.random.normal(ks[13], (DEPTH, D_MODEL), f32)
    ln2_b = 0.02 * jax.random.normal(ks[14], (DEPTH, D_MODEL), f32)
    return {"x": x, "ln_emb_g": ln_emb_g, "ln_emb_b": ln_emb_b, "w_in": w_in,
            "lb_fwd_logits": lb_fwd_logits, "lb_bwd_logits": lb_bwd_logits, "g_norm": g_norm,
            "w_out": w_out, "ln1_g": ln1_g, "ln1_b": ln1_b, "w_gate": w_gate, "w_up": w_up,
            "w_down": w_down, "ln2_g": ln2_g, "ln2_b": ln2_b}


def reference(x, ln_emb_g, ln_emb_b, w_in, lb_fwd_logits, lb_bwd_logits, g_norm,
              w_out, ln1_g, ln1_b, w_gate, w_up, w_down, ln2_g, ln2_b):
    lb_fwd_all = jnp.cumsum(jax.nn.softmax(lb_fwd_logits.astype(jnp.float32), axis=0), axis=0)
    lb_bwd_all = jnp.cumsum(jax.nn.softmax(lb_bwd_logits.astype(jnp.float32), axis=0), axis=0)
    h = _layernorm(x, ln_emb_g, ln_emb_b)
    W = HGRN_WIDTH
    for l in range(DEPTH):
        u = h @ w_in[l]
        q_raw = u[..., 0 * W:1 * W]
        i_raw = u[..., 1 * W:2 * W]
        zf = u[..., 2 * W:3 * W]
        zb = u[..., 3 * W:4 * W]
        g_raw = u[..., 4 * W:5 * W]
        u_four = u[..., 5 * W:5 * W + FOURIER_WIDTH]
        o_hgrn = _hgrn2_group(q_raw, i_raw, zf, zb, g_raw, lb_fwd_all[l], lb_bwd_all[l], g_norm[l])
        o_four = _fourier_group(u_four)
        mix = jnp.concatenate([o_hgrn, o_four], axis=-1) @ w_out[l]
        h = _layernorm(DEEPNORM_ALPHA * h + mix, ln1_g[l], ln1_b[l])
        ffn = (jax.nn.silu(h @ w_gate[l]) * (h @ w_up[l])) @ w_down[l]
        h = _layernorm(DEEPNORM_ALPHA * h + ffn, ln2_g[l], ln2_b[l])
    return h
```

```cpp
#include <hip/hip_runtime.h>
#include <hip/hip_cooperative_groups.h>
#include <cstdio>
#include <cstdint>
namespace cg = cooperative_groups;

#ifndef N_LAUNCH_MODE
#define N_LAUNCH_MODE 0
#endif

#define LAS __attribute__((address_space(3)))
typedef _Float16 h16;
typedef _Float16 h16x8 __attribute__((ext_vector_type(8)));
typedef _Float16 h16x4 __attribute__((ext_vector_type(4)));
typedef _Float16 h16x2 __attribute__((ext_vector_type(2)));
typedef short s16x8 __attribute__((ext_vector_type(8)));
typedef float f32x4 __attribute__((ext_vector_type(4)));
typedef float f32x2 __attribute__((ext_vector_type(2)));
typedef unsigned u32x4 __attribute__((ext_vector_type(4)));
typedef unsigned u32x2 __attribute__((ext_vector_type(2)));

constexpr int T = 8192, D = 2048, PW = 6144, FF = 5632, HW = 1024;
constexpr float ALPHA = 1.189207115002721f;
constexpr float LN_EPS = 1e-5f, RMS_EPS = 1e-6f;
constexpr size_t MiB = 1ull << 20;
constexpr size_t OFF_H0 = 0;
constexpr size_t OFF_WOUT = 32 * MiB;
constexpr size_t OFF_WIN = 40 * MiB;
constexpr size_t OFF_U = 64 * MiB;
constexpr size_t OFF_PQ = 160 * MiB;
constexpr size_t OFF_DEC = 240 * MiB;
constexpr size_t OFF_TAB = 241 * MiB;
constexpr size_t OFF_ODIR = 40 * MiB;
constexpr size_t OFF_MIX = 104 * MiB;
constexpr size_t OFF_WGU = 160 * MiB;
constexpr size_t OFF_WD = 204 * MiB;
constexpr size_t OFF_ACT = 40 * MiB;
constexpr size_t WS_NEED = 242 * MiB;
constexpr size_t UBLK = (size_t)T * 1024;
constexpr int REC_BYTES = 40960;
constexpr int LDS_BYTES = 131072;

struct Params {
    const float *x, *ln_emb_g, *ln_emb_b, *w_in, *lbf, *lbb, *g_norm, *w_out, *ln1_g, *ln1_b, *w_gate, *w_up, *w_down, *ln2_g, *ln2_b;
    float* out; unsigned char* ws; int ph_lo, ph_hi;
};

__device__ __forceinline__ float wave_sum(float v) {
#pragma unroll
    for (int o = 1; o < 64; o <<= 1) v += __shfl_xor(v, o);
    return v;
}
__device__ __forceinline__ float silu_f(float x) { return x * __builtin_amdgcn_rcpf(1.0f + __expf(-x)); }
__device__ __forceinline__ unsigned short f2bf(float f) { unsigned u = __float_as_uint(f); u += 0x7FFFu + ((u >> 16) & 1u); return (unsigned short)(u >> 16); }
__device__ __forceinline__ unsigned pkh(float a, float b) { h16x2 v; v.x = (h16)a; v.y = (h16)b; return __builtin_bit_cast(unsigned, v); }
#define LDS_WAIT() asm volatile("s_waitcnt lgkmcnt(0)" ::: "memory")

namespace pg8 {
constexpr int BM = 256, BK = 64, HALF = 128, HTB = HALF * BK * 2, STAGE_BYTES = 8 * HTB, NXCD = 8, WGM = 8;
__device__ __forceinline__ int lds_byte(int r, int c) { const int st = (r >> 4) * 2 + (c >> 5), rr = r & 15, cc = c & 31, ob = rr * 64 + cc * 2; return st * 1024 + (ob ^ (((ob >> 9) & 1) << 5)); }
__device__ __forceinline__ void stage_rc(int b, int& R, int& C) { const int st = b / 1024, sb = b % 1024, swz = sb ^ (((sb >> 9) & 1) << 5); R = (st >> 1) * 16 + swz / 64; C = (st & 1) * 32 + (swz % 64) / 2; }
__device__ __forceinline__ int perm32(int rho) { const int n = rho >> 4, i = rho & 15; return 8 * (i >> 2) + 4 * n + (i & 3); }
struct Unit { int pm, pn; };
struct Gemm { const h16* A; const h16* Bt; int M, N, K; };
struct StaticOrder {
    int nM, nN, nwg, G, c;
    __device__ void init(int M, int N, int G_, int c_) { nM = M / BM; nN = N / BM; nwg = nM * nN; G = G_; c = c_; }
    __device__ bool next(int i, Unit& u) const {
        const long L = (long)i * G + c; if (L >= nwg) return false;
        int wgid = (int)L; { const int q = nwg / NXCD, r = nwg % NXCD, xcd = wgid % NXCD, off = wgid / NXCD; wgid = (xcd < r ? xcd * (q + 1) : r * (q + 1) + (xcd - r) * q) + off; }
        const int nig = WGM * nN, gid = wgid / nig, fm = gid * WGM, gsz = (nM - fm) < WGM ? (nM - fm) : WGM;
        u.pm = fm + ((wgid % nig) % gsz); u.pn = (wgid % nig) / gsz; return true;
    }
};

template <class Epi>
__device__ __forceinline__ void gemm_phase(LAS unsigned char* lds, const Gemm g, const StaticOrder& S, const Epi& E) {
    const int tid = threadIdx.x, wid = __builtin_amdgcn_readfirstlane(tid >> 6), lane = tid & 63, wr = wid >> 2, wc = wid & 3, fr = lane & 15, fq = lane >> 4;
    const int K = g.K, nt = K / BK;
    unsigned voffA[2], voffB[2];
#pragma unroll
    for (int i = 0; i < 2; ++i) { int R, C; stage_rc(tid * 16 + i * 8192, R, C); const int Rb = Epi::PERM ? ((R & ~31) + perm32(R & 31)) : R;
        voffA[i] = (unsigned)(R * K + C) * 2u; voffB[i] = (unsigned)(Rb * K + C) * 2u; }
    const size_t kstep = (size_t)(BK * 2);
    const size_t hstep = (size_t)HALF * K * 2;
    const size_t tstep = 2 * hstep;
    const unsigned ldsw = (unsigned)wid * 1024u;
    const int aoff = lds_byte(wr * 64 + fr, fq * 8), boff = lds_byte(wc * 32 + fr, fq * 8);
#define PG8_SA(b, h) (((b) * 2 + (h)) * HTB)
#define PG8_SB(b, h) ((4 + (b) * 2 + (h)) * HTB)
#define PG8_STAGE(bufoff, gbase, voff) do { _Pragma("unroll") for (int _i = 0; _i < 2; ++_i) \
        __builtin_amdgcn_global_load_lds((const unsigned*)((const char*)(gbase) + (voff)[_i]), (LAS unsigned*)(lds + (bufoff) + ldsw + _i * 8192), 16, 0, 0); } while (0)
#define PG8_LDA(dst, b, h) do { _Pragma("unroll") for (int m = 0; m < 4; ++m) _Pragma("unroll") for (int k = 0; k < 2; ++k) dst[m][k] = *(const LAS h16x8*)(lds + PG8_SA(b, h) + aoff + m * 2048 + k * 1024); } while (0)
#define PG8_LDB(dst, b, h) do { _Pragma("unroll") for (int n = 0; n < 2; ++n) _Pragma("unroll") for (int k = 0; k < 2; ++k) dst[n][k] = *(const LAS h16x8*)(lds + PG8_SB(b, h) + boff + n * 2048 + k * 1024); } while (0)
#define PG8_MMA(ai, bj, At, Bt) do { __builtin_amdgcn_s_setprio(1); _Pragma("unroll") for (int m = 0; m < 4; ++m) _Pragma("unroll") for (int n = 0; n < 2; ++n) _Pragma("unroll") for (int k = 0; k < 2; ++k) \
        acc[ai][bj][m][n] = __builtin_amdgcn_mfma_f32_16x16x32_f16(Bt[n][k], At[m][k], acc[ai][bj][m][n], 0, 0, 0); __builtin_amdgcn_s_setprio(0); } while (0)
#define PG8_WAIT_V(n) asm volatile("s_waitcnt vmcnt(" #n ")" ::: "memory")
#define PG8_WAIT_L(n) asm volatile("s_waitcnt lgkmcnt(" #n ")" ::: "memory")
#define PG8_BAR __builtin_amdgcn_s_barrier()
#define PG8_SCHED __builtin_amdgcn_sched_barrier(0)
    Unit cur, nxt; int ui = 0;
    if (!S.next(0, cur)) return;
    f32x4 acc[2][2][4][2];
#pragma unroll
    for (int a = 0; a < 2; ++a)
#pragma unroll
        for (int b = 0; b < 2; ++b)
#pragma unroll
            for (int m = 0; m < 4; ++m)
#pragma unroll
                for (int n = 0; n < 2; ++n) acc[a][b][m][n] = (f32x4){0.f, 0.f, 0.f, 0.f};
    h16x8 At[4][2], B0[2][2], B1[2][2];
    const char* cA = (const char*)g.A + (size_t)cur.pm * tstep; const char* cB = (const char*)g.Bt + (size_t)cur.pn * tstep;
    PG8_STAGE(PG8_SB(0, 0), cB, voffB); PG8_STAGE(PG8_SA(0, 0), cA, voffA); PG8_STAGE(PG8_SB(0, 1), cB + hstep, voffB); PG8_STAGE(PG8_SA(0, 1), cA + hstep, voffA);
    if (wr == 1) PG8_BAR;
    PG8_WAIT_V(4); PG8_BAR;
    PG8_STAGE(PG8_SB(1, 0), cB + kstep, voffB); PG8_STAGE(PG8_SA(1, 0), cA + kstep, voffA); PG8_STAGE(PG8_SB(1, 1), cB + hstep + kstep, voffB);
    PG8_WAIT_V(6); PG8_BAR;
    for (;;) {
        const bool has_next = S.next(ui + 1, nxt);
        const char* nA = has_next ? (const char*)g.A + (size_t)nxt.pm * tstep : cA; const char* nB = has_next ? (const char*)g.Bt + (size_t)nxt.pn * tstep : cB;
        for (int t = 0; t < nt; t += 2) {
            const bool last = (t == nt - 2);
            const char* a1 = cA + (size_t)(t + 1) * kstep;
            const char* a2 = last ? nA : cA + (size_t)(t + 2) * kstep; const char* b2 = last ? nB : cB + (size_t)(t + 2) * kstep;
            const char* a3 = a2 + kstep; const char* b3 = b2 + kstep;
            PG8_LDB(B0, 0, 0); PG8_SCHED; PG8_LDA(At, 0, 0); PG8_STAGE(PG8_SA(1, 1), a1 + hstep, voffA);
            PG8_WAIT_L(8); PG8_BAR; PG8_WAIT_L(0); PG8_MMA(0, 0, At, B0); PG8_BAR; PG8_SCHED;
            PG8_LDB(B1, 0, 1); PG8_STAGE(PG8_SB(0, 0), b2, voffB);
            PG8_BAR; PG8_WAIT_L(0); PG8_MMA(0, 1, At, B1); PG8_BAR;
            PG8_LDA(At, 0, 1); PG8_STAGE(PG8_SA(0, 0), a2, voffA);
            PG8_BAR; PG8_WAIT_L(0); PG8_MMA(1, 0, At, B0); PG8_BAR; PG8_SCHED;
            PG8_STAGE(PG8_SB(0, 1), b2 + hstep, voffB);
            PG8_WAIT_V(6); PG8_BAR; PG8_MMA(1, 1, At, B1); PG8_BAR;
            PG8_LDB(B0, 1, 0); PG8_SCHED; PG8_LDA(At, 1, 0); PG8_STAGE(PG8_SA(0, 1), a2 + hstep, voffA);
            PG8_WAIT_L(8); PG8_BAR; PG8_WAIT_L(0); PG8_MMA(0, 0, At, B0); PG8_BAR; PG8_SCHED;
            PG8_LDB(B1, 1, 1); PG8_STAGE(PG8_SB(1, 0), b3, voffB);
            PG8_BAR; PG8_WAIT_L(0); PG8_MMA(0, 1, At, B1); PG8_BAR;
            PG8_LDA(At, 1, 1); PG8_STAGE(PG8_SA(1, 0), a3, voffA);
            PG8_BAR; PG8_WAIT_L(0); PG8_MMA(1, 0, At, B0); PG8_BAR; PG8_SCHED;
            PG8_STAGE(PG8_SB(1, 1), b3 + hstep, voffB);
            PG8_WAIT_V(6); PG8_BAR; PG8_MMA(1, 1, At, B1); PG8_BAR;
        }
        E(acc, cur, wr, wc, fr, fq);
        if (!has_next) break;
#pragma unroll
        for (int a = 0; a < 2; ++a)
#pragma unroll
            for (int b = 0; b < 2; ++b)
#pragma unroll
                for (int m = 0; m < 4; ++m)
#pragma unroll
                    for (int n = 0; n < 2; ++n) acc[a][b][m][n] = (f32x4){0.f, 0.f, 0.f, 0.f};
        cur = nxt; cA = nA; cB = nB; ++ui;
    }
    PG8_WAIT_V(0);
    if (wr == 0) PG8_BAR;
    PG8_BAR;
#undef PG8_SA
#undef PG8_SB
#undef PG8_STAGE
#undef PG8_LDA
#undef PG8_LDB
#undef PG8_MMA
#undef PG8_WAIT_V
#undef PG8_WAIT_L
#undef PG8_BAR
#undef PG8_SCHED
}

struct EpiU {
    static constexpr bool PERM = true;
    h16* ubase;
    __device__ __forceinline__ void operator()(const f32x4 (&acc)[2][2][4][2], const Unit& u, int wr, int wc, int fr, int fq) const {
        const int row0 = u.pm * BM + wr * 64 + fr; int colt = u.pn * BM; const int blk = colt >> 10; colt &= 1023;
        const int dblk = blk == 4 ? 5 : (blk == 5 ? 4 : blk);
        h16* base = ubase + (size_t)dblk * UBLK; const bool act = (blk == 0) || (blk == 4);
        const int col0 = colt + wc * 32 + 8 * fq;
#pragma unroll
        for (int ai = 0; ai < 2; ++ai)
#pragma unroll
            for (int m = 0; m < 4; ++m) { h16* rowp = base + (size_t)(row0 + ai * HALF + m * 16) * 1024 + col0;
#pragma unroll
                for (int bj = 0; bj < 2; ++bj) { f32x4 v0 = acc[ai][bj][m][0], v1 = acc[ai][bj][m][1];
                    if (act) {
#pragma unroll
                        for (int j = 0; j < 4; ++j) { v0[j] = silu_f(v0[j]); v1[j] = silu_f(v1[j]); } }
                    u32x4 w; w.x = pkh(v0[0], v0[1]); w.y = pkh(v0[2], v0[3]); w.z = pkh(v1[0], v1[1]); w.w = pkh(v1[2], v1[3]);
                    *(u32x4*)(rowp + bj * HALF) = w; } }
    }
};
struct EpiRes {
    static constexpr bool PERM = false;
    float* Y; const h16* H;
    __device__ __forceinline__ void operator()(const f32x4 (&acc)[2][2][4][2], const Unit& u, int wr, int wc, int fr, int fq) const {
        const int row0 = u.pm * BM + wr * 64 + fr, col0 = u.pn * BM + wc * 32 + 4 * fq;
#pragma unroll
        for (int ai = 0; ai < 2; ++ai)
#pragma unroll
            for (int m = 0; m < 4; ++m) { const size_t ro = (size_t)(row0 + ai * HALF + m * 16) * D + col0;
#pragma unroll
                for (int bj = 0; bj < 2; ++bj)
#pragma unroll
                    for (int n = 0; n < 2; ++n) { const h16x4 hv = *(const h16x4*)(H + ro + bj * HALF + n * 16);
                        f32x4 y = acc[ai][bj][m][n]; y[0] += ALPHA * (float)hv[0]; y[1] += ALPHA * (float)hv[1]; y[2] += ALPHA * (float)hv[2]; y[3] += ALPHA * (float)hv[3];
                        *(f32x4*)(Y + ro + bj * HALF + n * 16) = y; } }
    }
};
struct EpiGlu {
    static constexpr bool PERM = true;
    h16* O;
    __device__ __forceinline__ void operator()(const f32x4 (&acc)[2][2][4][2], const Unit& u, int wr, int wc, int fr, int fq) const {
        const int row0 = u.pm * BM + wr * 64 + fr, col0 = u.pn * HALF + wc * 32 + 8 * fq;
#pragma unroll
        for (int ai = 0; ai < 2; ++ai)
#pragma unroll
            for (int m = 0; m < 4; ++m) { h16* rowp = O + (size_t)(row0 + ai * HALF + m * 16) * FF + col0;
                const f32x4 g0 = acc[ai][0][m][0], g1 = acc[ai][0][m][1], u0 = acc[ai][1][m][0], u1 = acc[ai][1][m][1];
                float r[8];
#pragma unroll
                for (int j = 0; j < 4; ++j) { r[j] = silu_f(g0[j]) * u0[j]; r[4 + j] = silu_f(g1[j]) * u1[j]; }
                u32x4 w; w.x = pkh(r[0], r[1]); w.y = pkh(r[2], r[3]); w.z = pkh(r[4], r[5]); w.w = pkh(r[6], r[7]);
                *(u32x4*)rowp = w; }
    }
};
}

template <class RM>
__device__ __forceinline__ void transpose_item(const float* W, int K, int N, h16* WT, LAS float* scr, int item, int lane, RM rm) {
    const int nblk = N / 32, kb = item / nblk, nb = item % nblk, k0 = 64 * kb, n0 = 32 * nb;
#pragma unroll 8
    for (int i = 0; i < 32; ++i) { const int kk = 2 * i + (lane >> 5); scr[kk * 33 + (lane & 31)] = W[(size_t)(k0 + kk) * N + n0 + (lane & 31)]; }
    LDS_WAIT();
    const int c = lane & 7;
#pragma unroll
    for (int j = 0; j < 4; ++j) { const int n = (lane >> 3) + 8 * j; const LAS float* s = scr + (8 * c) * 33 + n;
        u32x4 o; o.x = pkh(s[0 * 33], s[1 * 33]); o.y = pkh(s[2 * 33], s[3 * 33]); o.z = pkh(s[4 * 33], s[5 * 33]); o.w = pkh(s[6 * 33], s[7 * 33]);
        *(u32x4*)(WT + (size_t)rm(n0 + n) * K + k0 + 8 * c) = o; }
    LDS_WAIT();
}
struct RmId { __device__ __forceinline__ int operator()(int n) const { return n; } };
struct RmGate { __device__ __forceinline__ int operator()(int n) const { return (n >> 7) * 256 + (n & 127); } };
struct RmUp { __device__ __forceinline__ int operator()(int n) const { return (n >> 7) * 256 + 128 + (n & 127); } };

template <bool F32OUT>
__device__ __forceinline__ void ln_row(const float* xrow, const float* gam, const float* bet, void* orow, int lane) {
    const f32x4* xr = (const f32x4*)xrow + lane;
    f32x4 v[8]; float s = 0.f;
#pragma unroll
    for (int j = 0; j < 8; ++j) { v[j] = xr[64 * j]; s += (v[j][0] + v[j][1]) + (v[j][2] + v[j][3]); }
    const float mean = wave_sum(s) * (1.f / D); float s2 = 0.f;
#pragma unroll
    for (int j = 0; j < 8; ++j) { v[j] = v[j] - mean; s2 += (v[j][0] * v[j][0] + v[j][1] * v[j][1]) + (v[j][2] * v[j][2] + v[j][3] * v[j][3]); }
    const float rstd = __builtin_amdgcn_rsqf(wave_sum(s2) * (1.f / D) + LN_EPS);
#pragma unroll
    for (int j = 0; j < 8; ++j) {
        const f32x4 gg = *((const f32x4*)gam + 64 * j + lane), bb = *((const f32x4*)bet + 64 * j + lane);
        f32x4 y = v[j] * rstd * gg + bb;
        if (F32OUT) *((f32x4*)orow + 64 * j + lane) = y;
        else { u32x2 w; w.x = pkh(y[0], y[1]); w.y = pkh(y[2], y[3]); *((u32x2*)orow + 64 * j + lane) = w; }
    }
}

__device__ __forceinline__ void phase0(const Params& p, LAS unsigned char* lds) {
    const int tid = threadIdx.x, lane = tid & 63, wave = tid >> 6, G = gridDim.x;
    const int gw = blockIdx.x * 8 + wave, NGW = G * 8;
    h16* h0 = (h16*)(p.ws + OFF_H0);
    {
        h16* FcT = (h16*)(p.ws + OFF_TAB); h16* F128 = FcT + 512 * 256; h16* G64 = F128 + 256 * 256;
        const int gt = blockIdx.x * 512 + tid, NT = G * 512;
        for (int i = gt; i < 512 * 256; i += NT) { const int nn = i >> 8, c = i & 255, cp = nn >> 1, ri = nn & 1; const float fr = (float)((c * cp) & 255) * (1.f / 256.f);
            FcT[i] = (h16)((ri ? -__builtin_amdgcn_sinf(fr) : __builtin_amdgcn_cosf(fr)) * 0.0625f); }
        for (int i = gt; i < 256 * 256; i += NT) { const int rho = i >> 8, kap = i & 255, ka = rho >> 1, rp = rho & 1, ri = kap >> 7, th = kap & 127; const float fr = (float)((ka * th) & 127) * (1.f / 128.f);
            const float cs = __builtin_amdgcn_cosf(fr), sn = __builtin_amdgcn_sinf(fr); const float v = rp == 0 ? (ri == 0 ? cs : sn) : (ri == 0 ? -sn : cs);
            F128[i] = (h16)(v * 0.08838834764831845f); }
        for (int i = gt; i < 64 * 128; i += NT) { const int kb = i >> 7, kk = i & 127, ri = kk >> 6, tl = kk & 63; const float fr = (float)((kb * tl) & 63) * (1.f / 64.f);
            G64[i] = (h16)((ri ? __builtin_amdgcn_sinf(fr) : __builtin_amdgcn_cosf(fr)) * 0.125f); }
    }
    for (int r = gw; r < T; r += NGW) ln_row<false>(p.x + (size_t)r * D, p.ln_emb_g, p.ln_emb_b, h0 + (size_t)r * D, lane);
    LAS float* scr = (LAS float*)(lds + wave * 8448);
    constexpr int I_IN = (D / 64) * (PW / 32), I_OUT = (D / 64) * (D / 32);
    for (int it = gw; it < I_IN + I_OUT; it += NGW) {
        if (it < I_IN) transpose_item(p.w_in, D, PW, (h16*)(p.ws + OFF_WIN), scr, it, lane, RmId());
        else transpose_item(p.w_out, D, D, (h16*)(p.ws + OFF_WOUT), scr, it - I_IN, lane, RmId());
    }
}

__device__ __forceinline__ void fa_tile(const Params& p, LAS unsigned char* lds, int tile) {
    const int tid = threadIdx.x, lane = tid & 63, w = __builtin_amdgcn_readfirstlane(tid >> 6), r = lane & 15, g = lane >> 4;
    const int t_lo = tile & 63, grp = tile >> 6;
    const h16* U = (const h16*)(p.ws + OFF_U) + 4 * UBLK;
    const h16* FcT = (const h16*)(p.ws + OFF_TAB); const h16* F128 = FcT + 512 * 256;
    h16* Wtw = (h16*)p.out;
    LAS unsigned char* ldsZ = lds + 67584;
#pragma unroll
    for (int i = 0; i < 8; ++i) { const int idx = tid + 512 * i, row = idx >> 5, ch = idx & 31;
        const u32x4 v = *(const u32x4*)(U + (size_t)(t_lo + 64 * row) * 1024 + grp * 256 + ch * 8);
        *(LAS u32x4*)(lds + row * 528 + ch * 16) = v; }
    h16x8 FA3[2][8];
#pragma unroll
    for (int mi = 0; mi < 2; ++mi)
#pragma unroll
        for (int ks = 0; ks < 8; ++ks) FA3[mi][ks] = *(const h16x8*)(F128 + (16 * (2 * w + mi) + r) * 256 + 32 * ks + 8 * g);
    __syncthreads();
    for (int cb = 0; cb < 4; ++cb) {
        {
            h16x8 Bf[8];
#pragma unroll
            for (int ks = 0; ks < 8; ++ks) Bf[ks] = *(const h16x8*)(FcT + (cb * 128 + 16 * w + r) * 256 + 32 * ks + 8 * g);
            f32x4 acc[8];
#pragma unroll
            for (int mt = 0; mt < 8; ++mt) acc[mt] = (f32x4){0.f, 0.f, 0.f, 0.f};
#pragma unroll
            for (int mt = 0; mt < 8; ++mt)
#pragma unroll
                for (int ks = 0; ks < 8; ++ks) { const h16x8 a = *(const LAS h16x8*)(lds + (16 * mt + r) * 528 + (32 * ks + 8 * g) * 2);
                    acc[mt] = __builtin_amdgcn_mfma_f32_16x16x32_f16(a, Bf[ks], acc[mt], 0, 0, 0); }
            const int n_l = 16 * w + r, zrow = (n_l >> 1) * 264 + (n_l & 1) * 128;
#pragma unroll
            for (int mt = 0; mt < 8; ++mt) { u32x2 o; o.x = pkh(acc[mt][0], acc[mt][1]); o.y = pkh(acc[mt][2], acc[mt][3]);
                *(LAS u32x2*)(ldsZ + (zrow + 16 * mt + 4 * g) * 2) = o; }
        }
        __syncthreads();
        {
            f32x4 acc3[2][4];
#pragma unroll
            for (int mi = 0; mi < 2; ++mi)
#pragma unroll
                for (int nt = 0; nt < 4; ++nt) acc3[mi][nt] = (f32x4){0.f, 0.f, 0.f, 0.f};
#pragma unroll
            for (int ks = 0; ks < 8; ++ks)
#pragma unroll
                for (int nt = 0; nt < 4; ++nt) { const h16x8 b = *(const LAS h16x8*)(ldsZ + ((16 * nt + r) * 264 + 32 * ks + 8 * g) * 2);
#pragma unroll
                    for (int mi = 0; mi < 2; ++mi) acc3[mi][nt] = __builtin_amdgcn_mfma_f32_16x16x32_f16(FA3[mi][ks], b, acc3[mi][nt], 0, 0, 0); }
#pragma unroll
            for (int mi = 0; mi < 2; ++mi)
#pragma unroll
                for (int pp = 0; pp < 2; ++pp) { const int k_a = 8 * (2 * w + mi) + 2 * g + pp; const float ang = (float)(t_lo * k_a) * (1.f / 8192.f);
                    const float wr_ = __builtin_amdgcn_cosf(ang), wi_ = -__builtin_amdgcn_sinf(ang);
                    h16* dst = Wtw + ((((size_t)t_lo * 128 + k_a) * 4 + grp) * 256 + cb * 64 + r) * 2;
#pragma unroll
                    for (int nt = 0; nt < 4; ++nt) { const float re = acc3[mi][nt][2 * pp], im = acc3[mi][nt][2 * pp + 1];
                        *(unsigned*)(dst + nt * 32) = pkh(re * wr_ - im * wi_, re * wi_ + im * wr_); } }
        }
        __syncthreads();
    }
}

__device__ __forceinline__ void fb_tile(const Params& p, LAS unsigned char* lds, int tile, const h16x8 (&Bg)[4][4]) {
    const int tid = threadIdx.x, lane = tid & 63, w = __builtin_amdgcn_readfirstlane(tid >> 6), r = lane & 15, g = lane >> 4;
    const int k_a = tile & 127, grp = tile >> 7;
    const h16* Wtw = (const h16*)p.out;
    h16* mix = (h16*)(p.ws + OFF_MIX);
    LAS h16* ldsW = (LAS h16*)lds;
#pragma unroll
    for (int i = 0; i < 8; ++i) { const int idx = tid + 512 * i, t_lo = idx >> 6, ch = idx & 63;
        const h16x8 v = *(const h16x8*)(Wtw + ((((size_t)t_lo * 128 + k_a) * 4 + grp) * 256 + 4 * ch) * 2);
#pragma unroll
        for (int q = 0; q < 4; ++q) { ldsW[(4 * ch + q) * 136 + t_lo] = v[2 * q]; ldsW[(4 * ch + q) * 136 + 64 + t_lo] = v[2 * q + 1]; } }
    __syncthreads();
    f32x4 acc[2][4];
#pragma unroll
    for (int mi = 0; mi < 2; ++mi)
#pragma unroll
        for (int nt = 0; nt < 4; ++nt) acc[mi][nt] = (f32x4){0.f, 0.f, 0.f, 0.f};
#pragma unroll
    for (int ks = 0; ks < 4; ++ks)
#pragma unroll
        for (int mi = 0; mi < 2; ++mi) { const h16x8 a = *(const LAS h16x8*)(ldsW + (16 * (2 * w + mi) + r) * 136 + 32 * ks + 8 * g);
#pragma unroll
            for (int nt = 0; nt < 4; ++nt) acc[mi][nt] = __builtin_amdgcn_mfma_f32_16x16x32_f16(a, Bg[nt][ks], acc[mi][nt], 0, 0, 0); }
#pragma unroll
    for (int mi = 0; mi < 2; ++mi)
#pragma unroll
        for (int nt = 0; nt < 4; ++nt) { const int tp = k_a + 128 * (16 * nt + r); u32x2 o; o.x = pkh(acc[mi][nt][0], acc[mi][nt][1]); o.y = pkh(acc[mi][nt][2], acc[mi][nt][3]);
            *(u32x2*)(mix + (size_t)tp * D + 1024 + grp * 256 + 16 * (2 * w + mi) + 4 * g) = o; }
    __syncthreads();
}

__device__ __forceinline__ void prep_item(const Params& p, LAS unsigned char* lds, int item) {
    const int tid = threadIdx.x, lane = tid & 63, w = __builtin_amdgcn_readfirstlane(tid >> 6), r = lane & 15, g = lane >> 4;
    const int n = item & 127, h = (item >> 7) & 7, d = item >> 10;
    const h16* ub = (const h16*)(p.ws + OFF_U);
    const h16* uq = ub, *uv = ub + UBLK, *uz = ub + (size_t)(2 + d) * UBLK;
    unsigned char* rec = p.ws + OFF_PQ + (size_t)item * REC_BYTES;
    h16* vfr = (h16*)((unsigned char*)p.out + 32 * MiB + (size_t)item * 16384);
    float* dec = (float*)(p.ws + OFF_DEC) + (size_t)item * 128;
    LAS unsigned short* Qb = (LAS unsigned short*)lds;
    LAS unsigned short* KIb = (LAS unsigned short*)(lds + 17408);
    LAS h16* Qh = (LAS h16*)(lds + 34816);
    LAS float* segtot = (LAS float*)(lds + 52224);
    const int k = tid & 127, seg = tid >> 7, ch = h * 128 + k;
    const float* lbl = d ? p.lbb : p.lbf;
    const float lb = __builtin_amdgcn_rcpf(1.0f + __expf(lbl[1024 + ch] - lbl[ch]));
    float bc[16], kk[16];
    float run = 0.f;
#pragma unroll
    for (int jj = 0; jj < 16; ++jj) { const int tau = 64 * n + 16 * seg + jj, t = d ? (T - 1 - tau) : tau;
        const float z = (float)uz[(size_t)t * 1024 + ch];
        const float sg = __builtin_amdgcn_rcpf(1.0f + __expf(-z));
        const float f = lb + (1.0f - lb) * sg;
        run += __logf(f); bc[jj] = run; kk[jj] = 1.0f - f; }
    segtot[seg * 128 + k] = run;
    __syncthreads();
    float pre = 0.f, tot = 0.f;
#pragma unroll
    for (int s = 0; s < 4; ++s) { const float v = segtot[s * 128 + k]; tot += v; if (s < seg) pre += v; }
    if (seg == 0) dec[k] = __expf(tot);
    {
        u32x4 ke[2]; u32x4 vv[2];
        float kef[16]; h16 vvh[16];
#pragma unroll
        for (int jj = 0; jj < 16; ++jj) { const int j = 16 * seg + jj, tau = 64 * n + j, t = d ? (T - 1 - tau) : tau;
            const float b = pre + bc[jj];
            const float q = (float)uq[(size_t)t * 1024 + ch];
            const float qd = q * __expf(b);
            Qb[j * 136 + k] = f2bf(qd); Qh[j * 136 + k] = (h16)qd;
            KIb[j * 136 + k] = f2bf(kk[jj] * __expf(-b));
            kef[jj] = kk[jj] * __expf(tot - b);
            vvh[jj] = uv[(size_t)t * 1024 + ch]; }
#pragma unroll
        for (int hh = 0; hh < 2; ++hh) { ke[hh].x = pkh(kef[8 * hh + 0], kef[8 * hh + 1]); ke[hh].y = pkh(kef[8 * hh + 2], kef[8 * hh + 3]); ke[hh].z = pkh(kef[8 * hh + 4], kef[8 * hh + 5]); ke[hh].w = pkh(kef[8 * hh + 6], kef[8 * hh + 7]);
            h16x8 t8;
#pragma unroll
            for (int e = 0; e < 8; ++e) t8[e] = vvh[8 * hh + e];
            vv[hh] = __builtin_bit_cast(u32x4, t8); }
        const int mt = k >> 4, ksp = seg >> 1;
#pragma unroll
        for (int hh = 0; hh < 2; ++hh) { const int lp = (2 * (seg & 1) + hh) * 16 + (k & 15); const size_t fo = ((size_t)(mt * 2 + ksp) * 64 + lp) * 16;
            *(u32x4*)(rec + 24576 + fo) = ke[hh];
            *(u32x4*)((unsigned char*)vfr + fo) = vv[hh]; }
    }
    __syncthreads();
#pragma unroll
    for (int i = 0; i < 4; ++i) { const int gi = tid + 512 * i, lp = gi & 63, jt = (gi >> 6) & 3, wq = gi >> 8, rr = lp & 15, gg = lp >> 4;
        const u32x2 v = *(const LAS u32x2*)(Qh + (16 * jt + rr) * 136 + 16 * wq + 4 * gg);
        *(u32x2*)(rec + 8192 + (size_t)gi * 8) = v; }
    {
        const int jt = w >> 1;
#pragma unroll
        for (int si = 0; si < 2; ++si) { const int st = 2 * (w & 1) + si;
            f32x4 a4 = (f32x4){0.f, 0.f, 0.f, 0.f};
            if (st <= jt) {
#pragma unroll
                for (int ks = 0; ks < 4; ++ks) { const s16x8 a = *(const LAS s16x8*)(KIb + (16 * st + r) * 136 + 32 * ks + 8 * g); const s16x8 b = *(const LAS s16x8*)(Qb + (16 * jt + r) * 136 + 32 * ks + 8 * g);
                    a4 = __builtin_amdgcn_mfma_f32_16x16x32_bf16(__builtin_bit_cast(__bf16 __attribute__((ext_vector_type(8))), a), __builtin_bit_cast(__bf16 __attribute__((ext_vector_type(8))), b), a4, 0, 0, 0); }
            }
            const int j = 16 * jt + r;
#pragma unroll
            for (int i = 0; i < 4; ++i) { const int s = 16 * st + 4 * g + i; if (s > j) a4[i] = 0.f; }
            u32x2 o; o.x = pkh(a4[0], a4[1]); o.y = pkh(a4[2], a4[3]);
            const int lp = (2 * (st & 1) + (g >> 1)) * 16 + r;
            *(u32x2*)(rec + ((size_t)(jt * 2 + (st >> 1)) * 64 + lp) * 16 + 8 * (g & 1)) = o; }
    }
    __syncthreads();
}

struct StepLd { h16x8 ke0, ke1, bv0, bv1, pf; h16x4 q[4]; f32x4 dec; };
__device__ __forceinline__ void scan_load(StepLd& L, const unsigned char* rec0, const unsigned char* vf0, const float* dec0, int n, int w, int lane, int vs) {
    n = n < 127 ? n : 127;
    const unsigned char* rec = rec0 + (size_t)n * REC_BYTES;
    L.pf = *(const h16x8*)(rec + ((size_t)((w & 3) * 2 + (w >> 2)) * 64 + lane) * 16);
#pragma unroll
    for (int jt = 0; jt < 4; ++jt) L.q[jt] = *(const h16x4*)(rec + 8192 + ((size_t)(w * 4 + jt) * 64 + lane) * 8);
    L.ke0 = *(const h16x8*)(rec + 24576 + ((size_t)(w * 2 + 0) * 64 + lane) * 16);
    L.ke1 = *(const h16x8*)(rec + 24576 + ((size_t)(w * 2 + 1) * 64 + lane) * 16);
    const unsigned char* vf = vf0 + (size_t)n * 16384;
    L.bv0 = *(const h16x8*)(vf + ((size_t)(vs * 2 + 0) * 64 + lane) * 16);
    L.bv1 = *(const h16x8*)(vf + ((size_t)(vs * 2 + 1) * 64 + lane) * 16);
    L.dec = *(const f32x4*)(dec0 + (size_t)n * 128 + 16 * w + 4 * (lane >> 4));
}
__device__ __forceinline__ void scan_step(const StepLd& L, f32x4& S, LAS unsigned char* lds, float* od, int n, int d, int w, int lane) {
    const h16x4 sb = __builtin_convertvector(S, h16x4);
    f32x4 o[4];
#pragma unroll
    for (int jt = 0; jt < 4; ++jt) o[jt] = __builtin_amdgcn_mfma_f32_16x16x16f16(L.q[jt], sb, (f32x4){0.f, 0.f, 0.f, 0.f}, 0, 0, 0);
    const h16x8 bvp = (w >> 2) ? L.bv1 : L.bv0;
#pragma unroll
    for (int jt = 0; jt < 4; ++jt) if (jt == (w & 3)) o[jt] = __builtin_amdgcn_mfma_f32_16x16x32_f16(L.pf, bvp, o[jt], 0, 0, 0);
    S = S * L.dec;
    S = __builtin_amdgcn_mfma_f32_16x16x32_f16(L.ke0, L.bv0, S, 0, 0, 0);
    S = __builtin_amdgcn_mfma_f32_16x16x32_f16(L.ke1, L.bv1, S, 0, 0, 0);
    LAS unsigned char* pb = lds + (n & 1) * 32768;
#pragma unroll
    for (int jt = 0; jt < 4; ++jt) *(LAS f32x4*)(pb + ((w * 4 + jt) * 64 + lane) * 16) = o[jt];
    __syncthreads();
    if (w < 4) {
        f32x4 tot = (f32x4){0.f, 0.f, 0.f, 0.f};
#pragma unroll
        for (int ww = 0; ww < 8; ++ww) tot += *(const LAS f32x4*)(pb + ((ww * 4 + w) * 64 + lane) * 16);
        const int r = lane & 15, g = lane >> 4;
#pragma unroll
        for (int i = 0; i < 4; ++i) { const int tau = 64 * n + 16 * w + 4 * g + i, t = d ? (T - 1 - tau) : tau; od[(size_t)t * 1024 + r] = tot[i]; }
    }
}
__device__ __forceinline__ void scan_job(const Params& p, LAS unsigned char* lds, int job) {
    const int tid = threadIdx.x, lane = tid & 63, w = __builtin_amdgcn_readfirstlane(tid >> 6);
    const int vs = job & 7, h = (job >> 3) & 7, d = job >> 6;
    const size_t item0 = (size_t)(d * 8 + h) * 128;
    const unsigned char* rec0 = p.ws + OFF_PQ + item0 * REC_BYTES;
    const unsigned char* vf0 = (const unsigned char*)p.out + 32 * MiB + item0 * 16384;
    const float* dec0 = (const float*)(p.ws + OFF_DEC) + item0 * 128;
    float* od = (float*)(p.ws + OFF_ODIR) + (size_t)d * T * 1024 + h * 128 + vs * 16;
    f32x4 S = (f32x4){0.f, 0.f, 0.f, 0.f};
    StepLd b0, b1, b2, b3;
    scan_load(b0, rec0, vf0, dec0, 0, w, lane, vs); scan_load(b1, rec0, vf0, dec0, 1, w, lane, vs); scan_load(b2, rec0, vf0, dec0, 2, w, lane, vs);
    for (int n = 0; n < 128; n += 4) {
        scan_load(b3, rec0, vf0, dec0, n + 3, w, lane, vs); scan_step(b0, S, lds, od, n, d, w, lane);
        scan_load(b0, rec0, vf0, dec0, n + 4, w, lane, vs); scan_step(b1, S, lds, od, n + 1, d, w, lane);
        scan_load(b1, rec0, vf0, dec0, n + 5, w, lane, vs); scan_step(b2, S, lds, od, n + 2, d, w, lane);
        scan_load(b2, rec0, vf0, dec0, n + 6, w, lane, vs); scan_step(b3, S, lds, od, n + 3, d, w, lane);
    }
    __syncthreads();
}

__device__ __forceinline__ void phase4(const Params& p, LAS unsigned char* lds) {
    const int tid = threadIdx.x, lane = tid & 63, wave = tid >> 6, G = gridDim.x;
    const int gw = blockIdx.x * 8 + wave, NGW = G * 8;
    const float* of = (const float*)(p.ws + OFF_ODIR); const float* ob = of + (size_t)T * 1024;
    const h16* ug = (const h16*)(p.ws + OFF_U) + 5 * UBLK;
    h16* mix = (h16*)(p.ws + OFF_MIX);
    const f32x2 gn = *((const f32x2*)p.g_norm + lane);
    for (int it = gw; it < T * 8; it += NGW) { const int t = it >> 3, h = it & 7; const size_t o = (size_t)t * 1024 + h * 128 + 2 * lane;
        const f32x2 a = *(const f32x2*)(of + o), b = *(const f32x2*)(ob + o); const float o0 = a.x + b.x, o1 = a.y + b.y;
        const float ss = wave_sum(o0 * o0 + o1 * o1); const float rs = __builtin_amdgcn_rsqf(ss * (1.f / 128.f) + RMS_EPS);
        const h16x2 gv = *(const h16x2*)(ug + o);
        *(unsigned*)(mix + (size_t)t * D + h * 128 + 2 * lane) = pkh(o0 * rs * gn.x * (float)gv.x, o1 * rs * gn.y * (float)gv.y); }
    LAS float* scr = (LAS float*)(lds + wave * 8448);
    constexpr int I_G = (D / 64) * (FF / 32), I_D = (FF / 64) * (D / 32);
    for (int it = gw; it < 2 * I_G + I_D; it += NGW) {
        if (it < I_G) transpose_item(p.w_gate, D, FF, (h16*)(p.ws + OFF_WGU), scr, it, lane, RmGate());
        else if (it < 2 * I_G) transpose_item(p.w_up, D, FF, (h16*)(p.ws + OFF_WGU), scr, it - I_G, lane, RmUp());
        else transpose_item(p.w_down, FF, D, (h16*)(p.ws + OFF_WD), scr, it - 2 * I_G, lane, RmId());
    }
}

__global__ void __launch_bounds__(512, 2) fwd_megakernel(Params p) {
    extern __shared__ __attribute__((aligned(16))) unsigned char shm[];
    LAS unsigned char* lds = (LAS unsigned char*)shm;
    const int G = gridDim.x, bid = blockIdx.x, tid = threadIdx.x, lane = tid & 63, wave = tid >> 6;
    const int gw = bid * 8 + wave, NGW = G * 8;
#define RUN(ph) (p.ph_lo <= (ph) && (ph) < p.ph_hi)
#define SYNC(ph) do { if (p.ph_lo < (ph) && (ph) < p.ph_hi) cg::this_grid().sync(); } while (0)
    if (RUN(0)) phase0(p, lds);
    SYNC(1);
    if (RUN(1)) { pg8::Gemm g{(const h16*)(p.ws + OFF_H0), (const h16*)(p.ws + OFF_WIN), T, PW, D}; pg8::StaticOrder S; S.init(T, PW, G, bid);
        pg8::EpiU E{(h16*)(p.ws + OFF_U)}; pg8::gemm_phase(lds, g, S, E); }
    SYNC(2);
    if (RUN(2)) {
        for (int tile = bid; tile < 256; tile += G) fa_tile(p, lds, tile);
        for (int item = bid; item < 2048; item += G) prep_item(p, lds, item);
    }
    SYNC(3);
    if (RUN(3)) {
        for (int job = bid; job < 128; job += G) scan_job(p, lds, job);
        const int fb0 = G > 128 ? 128 : 0, nfb = G - fb0;
        if (bid >= fb0) {
            const int r = lane & 15, g = lane >> 4;
            const h16* G64 = (const h16*)(p.ws + OFF_TAB) + 512 * 256 + 256 * 256;
            h16x8 Bg[4][4];
#pragma unroll
            for (int nt = 0; nt < 4; ++nt)
#pragma unroll
                for (int ks = 0; ks < 4; ++ks) Bg[nt][ks] = *(const h16x8*)(G64 + (16 * nt + r) * 128 + 32 * ks + 8 * g);
            for (int tile = bid - fb0; tile < 512; tile += nfb) fb_tile(p, lds, tile, Bg);
        }
    }
    SYNC(4);
    if (RUN(4)) phase4(p, lds);
    SYNC(5);
    if (RUN(5)) { pg8::Gemm g{(const h16*)(p.ws + OFF_MIX), (const h16*)(p.ws + OFF_WOUT), T, D, D}; pg8::StaticOrder S; S.init(T, D, G, bid);
        pg8::EpiRes E{p.out, (const h16*)(p.ws + OFF_H0)}; pg8::gemm_phase(lds, g, S, E); }
    SYNC(6);
    if (RUN(6)) { h16* h1 = (h16*)(p.ws + OFF_H0);
        for (int r = gw; r < T; r += NGW) ln_row<false>(p.out + (size_t)r * D, p.ln1_g, p.ln1_b, h1 + (size_t)r * D, lane); }
    SYNC(7);
    if (RUN(7)) { pg8::Gemm g{(const h16*)(p.ws + OFF_H0), (const h16*)(p.ws + OFF_WGU), T, 2 * FF, D}; pg8::StaticOrder S; S.init(T, 2 * FF, G, bid);
        pg8::EpiGlu E{(h16*)(p.ws + OFF_ACT)}; pg8::gemm_phase(lds, g, S, E); }
    SYNC(8);
    if (RUN(8)) { pg8::Gemm g{(const h16*)(p.ws + OFF_ACT), (const h16*)(p.ws + OFF_WD), T, D, FF}; pg8::StaticOrder S; S.init(T, D, G, bid);
        pg8::EpiRes E{p.out, (const h16*)(p.ws + OFF_H0)}; pg8::gemm_phase(lds, g, S, E); }
    SYNC(9);
    if (RUN(9)) { for (int r = gw; r < T; r += NGW) ln_row<true>(p.out + (size_t)r * D, p.ln2_g, p.ln2_b, p.out + (size_t)r * D, lane); }
}

extern "C" void kernel_launch(void* const* d_in, const int* in_sizes, int n_in, void* d_out, int out_size, void* d_ws, size_t ws_size, hipStream_t stream) {
    static int grid = 0;
    if (grid == 0) {
        if (n_in != 15 || in_sizes[0] != T * D || out_size != T * D || ws_size < WS_NEED) { fprintf(stderr, "kernel_launch: unexpected shapes (n_in %d in0 %d out %d ws %zu)\n", n_in, n_in > 0 ? in_sizes[0] : -1, out_size, ws_size); grid = -1; return; }
        int dev = 0, cus = 0, per_cu = 0;
        hipGetDevice(&dev); hipDeviceGetAttribute(&cus, hipDeviceAttributeMultiprocessorCount, dev);
        if (hipFuncSetAttribute((const void*)fwd_megakernel, hipFuncAttributeMaxDynamicSharedMemorySize, LDS_BYTES) != hipSuccess) { fprintf(stderr, "kernel_launch: hipFuncSetAttribute failed\n"); grid = -1; return; }
        if (hipOccupancyMaxActiveBlocksPerMultiprocessor(&per_cu, (const void*)fwd_megakernel, 512, LDS_BYTES) != hipSuccess || per_cu < 1) { fprintf(stderr, "kernel_launch: occupancy query gave %d\n", per_cu); per_cu = 1; }
        (void)hipGetLastError();
        grid = cus * 1;
        if (grid > 256) grid = 256;
    }
    if (grid < 0) return;
    Params p{};
    p.x = (const float*)d_in[0]; p.ln_emb_g = (const float*)d_in[1]; p.ln_emb_b = (const float*)d_in[2]; p.w_in = (const float*)d_in[3];
    p.lbf = (const float*)d_in[4]; p.lbb = (const float*)d_in[5]; p.g_norm = (const float*)d_in[6]; p.w_out = (const float*)d_in[7];
    p.ln1_g = (const float*)d_in[8]; p.ln1_b = (const float*)d_in[9]; p.w_gate = (const float*)d_in[10]; p.w_up = (const float*)d_in[11];
    p.w_down = (const float*)d_in[12]; p.ln2_g = (const float*)d_in[13]; p.ln2_b = (const float*)d_in[14];
    p.out = (float*)d_out; p.ws = (unsigned char*)d_ws;
#if N_LAUNCH_MODE == 1
    p.ph_lo = 0; p.ph_hi = 10;
    void* args[] = {&p};
    hipError_t e = hipLaunchCooperativeKernel((const void*)fwd_megakernel, dim3(grid), dim3(512), args, LDS_BYTES, stream);
    if (e != hipSuccess) fprintf(stderr, "cooperative launch failed: %s (grid %d)\n", hipGetErrorString(e), grid);
#else
    for (int ph = 0; ph < 10; ++ph) { p.ph_lo = ph; p.ph_hi = ph + 1; hipLaunchKernelGGL(fwd_megakernel, dim3(grid), dim3(512), LDS_BYTES, stream, p); }
#endif
}
```

```cpp
#include <hip/hip_runtime.h>
#include <hip/hip_cooperative_groups.h>
#include <cstdio>
#include <cstdint>
namespace cg = cooperative_groups;

#ifndef N_LAUNCH_MODE
#define N_LAUNCH_MODE 1
#endif

#define LAS __attribute__((address_space(3)))
typedef _Float16 h16;
typedef _Float16 h16x8 __attribute__((ext_vector_type(8)));
typedef _Float16 h16x4 __attribute__((ext_vector_type(4)));
typedef _Float16 h16x2 __attribute__((ext_vector_type(2)));
typedef short s16x8 __attribute__((ext_vector_type(8)));
typedef float f32x4 __attribute__((ext_vector_type(4)));
typedef float f32x2 __attribute__((ext_vector_type(2)));
typedef unsigned u32x4 __attribute__((ext_vector_type(4)));
typedef unsigned u32x2 __attribute__((ext_vector_type(2)));

constexpr int T = 8192, D = 2048, PW = 6144, FF = 5632, HW = 1024;
constexpr float ALPHA = 1.189207115002721f;
constexpr float LN_EPS = 1e-5f, RMS_EPS = 1e-6f;
constexpr size_t MiB = 1ull << 20;
constexpr size_t OFF_H0 = 0;
constexpr size_t OFF_WOUT = 32 * MiB;
constexpr size_t OFF_WIN = 40 * MiB;
constexpr size_t OFF_U = 64 * MiB;
constexpr size_t OFF_PQ = 160 * MiB;
constexpr size_t OFF_DEC = 240 * MiB;
constexpr size_t OFF_TAB = 241 * MiB;
constexpr size_t OFF_ODIR = 40 * MiB;
constexpr size_t OFF_MIX = 104 * MiB;
constexpr size_t OFF_WGU = 160 * MiB;
constexpr size_t OFF_WD = 204 * MiB;
constexpr size_t OFF_ACT = 40 * MiB;
constexpr size_t WS_NEED = 242 * MiB;
constexpr size_t UBLK = (size_t)T * 1024;
constexpr int REC_BYTES = 40960;
constexpr int LDS_BYTES = 131072;

struct Params {
    const float *x, *ln_emb_g, *ln_emb_b, *w_in, *lbf, *lbb, *g_norm, *w_out, *ln1_g, *ln1_b, *w_gate, *w_up, *w_down, *ln2_g, *ln2_b;
    float* out; unsigned char* ws; int ph_lo, ph_hi;
};

__device__ __forceinline__ float wave_sum(float v) {
#pragma unroll
    for (int o = 1; o < 64; o <<= 1) v += __shfl_xor(v, o);
    return v;
}
__device__ __forceinline__ float silu_f(float x) { return x * __builtin_amdgcn_rcpf(1.0f + __expf(-x)); }
__device__ __forceinline__ unsigned short f2bf(float f) { unsigned u = __float_as_uint(f); u += 0x7FFFu + ((u >> 16) & 1u); return (unsigned short)(u >> 16); }
__device__ __forceinline__ unsigned pkh(float a, float b) { h16x2 v; v.x = (h16)a; v.y = (h16)b; return __builtin_bit_cast(unsigned, v); }
#define LDS_WAIT() asm volatile("s_waitcnt lgkmcnt(0)" ::: "memory")

namespace pg8 {
constexpr int BM = 256, BK = 64, HALF = 128, HTB = HALF * BK * 2, STAGE_BYTES = 8 * HTB, NXCD = 8, WGM = 8;
__device__ __forceinline__ int lds_byte(int r, int c) { const int st = (r >> 4) * 2 + (c >> 5), rr = r & 15, cc = c & 31, ob = rr * 64 + cc * 2; return st * 1024 + (ob ^ (((ob >> 9) & 1) << 5)); }
__device__ __forceinline__ void stage_rc(int b, int& R, int& C) { const int st = b / 1024, sb = b % 1024, swz = sb ^ (((sb >> 9) & 1) << 5); R = (st >> 1) * 16 + swz / 64; C = (st & 1) * 32 + (swz % 64) / 2; }
__device__ __forceinline__ int perm32(int rho) { const int n = rho >> 4, i = rho & 15; return 8 * (i >> 2) + 4 * n + (i & 3); }
struct Unit { int pm, pn; };
struct Gemm { const h16* A; const h16* Bt; int M, N, K; };
struct StaticOrder {
    int nM, nN, nwg, G, c;
    __device__ void init(int M, int N, int G_, int c_) { nM = M / BM; nN = N / BM; nwg = nM * nN; G = G_; c = c_; }
    __device__ bool next(int i, Unit& u) const {
        const long L = (long)i * G + c; if (L >= nwg) return false;
        int wgid = (int)L; { const int q = nwg / NXCD, r = nwg % NXCD, xcd = wgid % NXCD, off = wgid / NXCD; wgid = (xcd < r ? xcd * (q + 1) : r * (q + 1) + (xcd - r) * q) + off; }
        const int nig = WGM * nN, gid = wgid / nig, fm = gid * WGM, gsz = (nM - fm) < WGM ? (nM - fm) : WGM;
        u.pm = fm + ((wgid % nig) % gsz); u.pn = (wgid % nig) / gsz; return true;
    }
};

template <class Epi>
__device__ __forceinline__ void gemm_phase(LAS unsigned char* lds, const Gemm g, const StaticOrder& S, const Epi& E) {
    const int tid = threadIdx.x, wid = __builtin_amdgcn_readfirstlane(tid >> 6), lane = tid & 63, wr = wid >> 2, wc = wid & 3, fr = lane & 15, fq = lane >> 4;
    const int K = g.K, nt = K / BK;
    unsigned voffA[2], voffB[2];
#pragma unroll
    for (int i = 0; i < 2; ++i) { int R, C; stage_rc(tid * 16 + i * 8192, R, C); const int Rb = Epi::PERM ? ((R & ~31) + perm32(R & 31)) : R;
        voffA[i] = (unsigned)(R * K + C) * 2u; voffB[i] = (unsigned)(Rb * K + C) * 2u; }
    const size_t kstep = (size_t)(BK * 2);
    const size_t hstep = (size_t)HALF * K * 2;
    const size_t tstep = 2 * hstep;
    const unsigned ldsw = (unsigned)wid * 1024u;
    const int aoff = lds_byte(wr * 64 + fr, fq * 8), boff = lds_byte(wc * 32 + fr, fq * 8);
#define PG8_SA(b, h) (((b) * 2 + (h)) * HTB)
#define PG8_SB(b, h) ((4 + (b) * 2 + (h)) * HTB)
#define PG8_STAGE(bufoff, gbase, voff) do { _Pragma("unroll") for (int _i = 0; _i < 2; ++_i) \
        __builtin_amdgcn_global_load_lds((const unsigned*)((const char*)(gbase) + (voff)[_i]), (LAS unsigned*)(lds + (bufoff) + ldsw + _i * 8192), 16, 0, 0); } while (0)
#define PG8_LDA(dst, b, h) do { _Pragma("unroll") for (int m = 0; m < 4; ++m) _Pragma("unroll") for (int k = 0; k < 2; ++k) dst[m][k] = *(const LAS h16x8*)(lds + PG8_SA(b, h) + aoff + m * 2048 + k * 1024); } while (0)
#define PG8_LDB(dst, b, h) do { _Pragma("unroll") for (int n = 0; n < 2; ++n) _Pragma("unroll") for (int k = 0; k < 2; ++k) dst[n][k] = *(const LAS h16x8*)(lds + PG8_SB(b, h) + boff + n * 2048 + k * 1024); } while (0)
#define PG8_MMA(ai, bj, At, Bt) do { __builtin_amdgcn_s_setprio(1); _Pragma("unroll") for (int m = 0; m < 4; ++m) _Pragma("unroll") for (int n = 0; n < 2; ++n) _Pragma("unroll") for (int k = 0; k < 2; ++k) \
        acc[ai][bj][m][n] = __builtin_amdgcn_mfma_f32_16x16x32_f16(Bt[n][k], At[m][k], acc[ai][bj][m][n], 0, 0, 0); __builtin_amdgcn_s_setprio(0); } while (0)
#define PG8_WAIT_V(n) asm volatile("s_waitcnt vmcnt(" #n ")" ::: "memory")
#define PG8_WAIT_L(n) asm volatile("s_waitcnt lgkmcnt(" #n ")" ::: "memory")
#define PG8_BAR __builtin_amdgcn_s_barrier()
#define PG8_SCHED __builtin_amdgcn_sched_barrier(0)
    Unit cur, nxt; int ui = 0;
    if (!S.next(0, cur)) return;
    f32x4 acc[2][2][4][2];
#pragma unroll
    for (int a = 0; a < 2; ++a)
#pragma unroll
        for (int b = 0; b < 2; ++b)
#pragma unroll
            for (int m = 0; m < 4; ++m)
#pragma unroll
                for (int n = 0; n < 2; ++n) acc[a][b][m][n] = (f32x4){0.f, 0.f, 0.f, 0.f};
    h16x8 At[4][2], B0[2][2], B1[2][2];
    const char* cA = (const char*)g.A + (size_t)cur.pm * tstep; const char* cB = (const char*)g.Bt + (size_t)cur.pn * tstep;
    PG8_STAGE(PG8_SB(0, 0), cB, voffB); PG8_STAGE(PG8_SA(0, 0), cA, voffA); PG8_STAGE(PG8_SB(0, 1), cB + hstep, voffB); PG8_STAGE(PG8_SA(0, 1), cA + hstep, voffA);
    if (wr == 1) PG8_BAR;
    PG8_WAIT_V(4); PG8_BAR;
    PG8_STAGE(PG8_SB(1, 0), cB + kstep, voffB); PG8_STAGE(PG8_SA(1, 0), cA + kstep, voffA); PG8_STAGE(PG8_SB(1, 1), cB + hstep + kstep, voffB);
    PG8_WAIT_V(6); PG8_BAR;
    for (;;) {
        const bool has_next = S.next(ui + 1, nxt);
        const char* nA = has_next ? (const char*)g.A + (size_t)nxt.pm * tstep : cA; const char* nB = has_next ? (const char*)g.Bt + (size_t)nxt.pn * tstep : cB;
        for (int t = 0; t < nt; t += 2) {
            const bool last = (t == nt - 2);
            const char* a1 = cA + (size_t)(t + 1) * kstep;
            const char* a2 = last ? nA : cA + (size_t)(t + 2) * kstep; const char* b2 = last ? nB : cB + (size_t)(t + 2) * kstep;
            const char* a3 = a2 + kstep; const char* b3 = b2 + kstep;
            PG8_LDB(B0, 0, 0); PG8_SCHED; PG8_LDA(At, 0, 0); PG8_STAGE(PG8_SA(1, 1), a1 + hstep, voffA);
            PG8_WAIT_L(8); PG8_BAR; PG8_WAIT_L(0); PG8_MMA(0, 0, At, B0); PG8_BAR; PG8_SCHED;
            PG8_LDB(B1, 0, 1); PG8_STAGE(PG8_SB(0, 0), b2, voffB);
            PG8_BAR; PG8_WAIT_L(0); PG8_MMA(0, 1, At, B1); PG8_BAR;
            PG8_LDA(At, 0, 1); PG8_STAGE(PG8_SA(0, 0), a2, voffA);
            PG8_BAR; PG8_WAIT_L(0); PG8_MMA(1, 0, At, B0); PG8_BAR; PG8_SCHED;
            PG8_STAGE(PG8_SB(0, 1), b2 + hstep, voffB);
            PG8_WAIT_V(6); PG8_BAR; PG8_MMA(1, 1, At, B1); PG8_BAR;
            PG8_LDB(B0, 1, 0); PG8_SCHED; PG8_LDA(At, 1, 0); PG8_STAGE(PG8_SA(0, 1), a2 + hstep, voffA);
            PG8_WAIT_L(8); PG8_BAR; PG8_WAIT_L(0); PG8_MMA(0, 0, At, B0); PG8_BAR; PG8_SCHED;
            PG8_LDB(B1, 1, 1); PG8_STAGE(PG8_SB(1, 0), b3, voffB);
            PG8_BAR; PG8_WAIT_L(0); PG8_MMA(0, 1, At, B1); PG8_BAR;
            PG8_LDA(At, 1, 1); PG8_STAGE(PG8_SA(1, 0), a3, voffA);
            PG8_BAR; PG8_WAIT_L(0); PG8_MMA(1, 0, At, B0); PG8_BAR; PG8_SCHED;
            PG8_STAGE(PG8_SB(1, 1), b3 + hstep, voffB);
            PG8_WAIT_V(6); PG8_BAR; PG8_MMA(1, 1, At, B1); PG8_BAR;
        }
        E(acc, cur, wr, wc, fr, fq);
        if (!has_next) break;
#pragma unroll
        for (int a = 0; a < 2; ++a)
#pragma unroll
            for (int b = 0; b < 2; ++b)
#pragma unroll
                for (int m = 0; m < 4; ++m)
#pragma unroll
                    for (int n = 0; n < 2; ++n) acc[a][b][m][n] = (f32x4){0.f, 0.f, 0.f, 0.f};
        cur = nxt; cA = nA; cB = nB; ++ui;
    }
    PG8_WAIT_V(0);
    if (wr == 0) PG8_BAR;
    PG8_BAR;
#undef PG8_SA
#undef PG8_SB
#undef PG8_STAGE
#undef PG8_LDA
#undef PG8_LDB
#undef PG8_MMA
#undef PG8_WAIT_V
#undef PG8_WAIT_L
#undef PG8_BAR
#undef PG8_SCHED
}

struct EpiU {
    static constexpr bool PERM = true;
    h16* ubase;
    __device__ __forceinline__ void operator()(const f32x4 (&acc)[2][2][4][2], const Unit& u, int wr, int wc, int fr, int fq) const {
        const int row0 = u.pm * BM + wr * 64 + fr; int colt = u.pn * BM; const int blk = colt >> 10; colt &= 1023;
        const int dblk = blk == 4 ? 5 : (blk == 5 ? 4 : blk);
        h16* base = ubase + (size_t)dblk * UBLK; const bool act = (blk == 0) || (blk == 4);
        const int col0 = colt + wc * 32 + 8 * fq;
#pragma unroll
        for (int ai = 0; ai < 2; ++ai)
#pragma unroll
            for (int m = 0; m < 4; ++m) { h16* rowp = base + (size_t)(row0 + ai * HALF + m * 16) * 1024 + col0;
#pragma unroll
                for (int bj = 0; bj < 2; ++bj) { f32x4 v0 = acc[ai][bj][m][0], v1 = acc[ai][bj][m][1];
                    if (act) {
#pragma unroll
                        for (int j = 0; j < 4; ++j) { v0[j] = silu_f(v0[j]); v1[j] = silu_f(v1[j]); } }
                    u32x4 w; w.x = pkh(v0[0], v0[1]); w.y = pkh(v0[2], v0[3]); w.z = pkh(v1[0], v1[1]); w.w = pkh(v1[2], v1[3]);
                    *(u32x4*)(rowp + bj * HALF) = w; } }
    }
};
struct EpiRes {
    static constexpr bool PERM = false;
    float* Y; const h16* H;
    __device__ __forceinline__ void operator()(const f32x4 (&acc)[2][2][4][2], const Unit& u, int wr, int wc, int fr, int fq) const {
        const int row0 = u.pm * BM + wr * 64 + fr, col0 = u.pn * BM + wc * 32 + 4 * fq;
#pragma unroll
        for (int ai = 0; ai < 2; ++ai)
#pragma unroll
            for (int m = 0; m < 4; ++m) { const size_t ro = (size_t)(row0 + ai * HALF + m * 16) * D + col0;
#pragma unroll
                for (int bj = 0; bj < 2; ++bj)
#pragma unroll
                    for (int n = 0; n < 2; ++n) { const h16x4 hv = *(const h16x4*)(H + ro + bj * HALF + n * 16);
                        f32x4 y = acc[ai][bj][m][n]; y[0] += ALPHA * (float)hv[0]; y[1] += ALPHA * (float)hv[1]; y[2] += ALPHA * (float)hv[2]; y[3] += ALPHA * (float)hv[3];
                        *(f32x4*)(Y + ro + bj * HALF + n * 16) = y; } }
    }
};
struct EpiGlu {
    static constexpr bool PERM = true;
    h16* O;
    __device__ __forceinline__ void operator()(const f32x4 (&acc)[2][2][4][2], const Unit& u, int wr, int wc, int fr, int fq) const {
        const int row0 = u.pm * BM + wr * 64 + fr, col0 = u.pn * HALF + wc * 32 + 8 * fq;
#pragma unroll
        for (int ai = 0; ai < 2; ++ai)
#pragma unroll
            for (int m = 0; m < 4; ++m) { h16* rowp = O + (size_t)(row0 + ai * HALF + m * 16) * FF + col0;
                const f32x4 g0 = acc[ai][0][m][0], g1 = acc[ai][0][m][1], u0 = acc[ai][1][m][0], u1 = acc[ai][1][m][1];
                float r[8];
#pragma unroll
                for (int j = 0; j < 4; ++j) { r[j] = silu_f(g0[j]) * u0[j]; r[4 + j] = silu_f(g1[j]) * u1[j]; }
                u32x4 w; w.x = pkh(r[0], r[1]); w.y = pkh(r[2], r[3]); w.z = pkh(r[4], r[5]); w.w = pkh(r[6], r[7]);
                *(u32x4*)rowp = w; }
    }
};
}

template <class RM>
__device__ __forceinline__ void transpose_item(const float* W, int K, int N, h16* WT, LAS float* scr, int item, int lane, RM rm) {
    const int nblk = N / 32, kb = item / nblk, nb = item % nblk, k0 = 64 * kb, n0 = 32 * nb;
#pragma unroll 8
    for (int i = 0; i < 32; ++i) { const int kk = 2 * i + (lane >> 5); scr[kk * 33 + (lane & 31)] = W[(size_t)(k0 + kk) * N + n0 + (lane & 31)]; }
    LDS_WAIT();
    const int c = lane & 7;
#pragma unroll
    for (int j = 0; j < 4; ++j) { const int n = (lane >> 3) + 8 * j; const LAS float* s = scr + (8 * c) * 33 + n;
        u32x4 o; o.x = pkh(s[0 * 33], s[1 * 33]); o.y = pkh(s[2 * 33], s[3 * 33]); o.z = pkh(s[4 * 33], s[5 * 33]); o.w = pkh(s[6 * 33], s[7 * 33]);
        *(u32x4*)(WT + (size_t)rm(n0 + n) * K + k0 + 8 * c) = o; }
    LDS_WAIT();
}
struct RmId { __device__ __forceinline__ int operator()(int n) const { return n; } };
struct RmGate { __device__ __forceinline__ int operator()(int n) const { return (n >> 7) * 256 + (n & 127); } };
struct RmUp { __device__ __forceinline__ int operator()(int n) const { return (n >> 7) * 256 + 128 + (n & 127); } };

template <bool F32OUT>
__device__ __forceinline__ void ln_row(const float* xrow, const float* gam, const float* bet, void* orow, int lane) {
    const f32x4* xr = (const f32x4*)xrow + lane;
    f32x4 v[8]; float s = 0.f;
#pragma unroll
    for (int j = 0; j < 8; ++j) { v[j] = xr[64 * j]; s += (v[j][0] + v[j][1]) + (v[j][2] + v[j][3]); }
    const float mean = wave_sum(s) * (1.f / D); float s2 = 0.f;
#pragma unroll
    for (int j = 0; j < 8; ++j) { v[j] = v[j] - mean; s2 += (v[j][0] * v[j][0] + v[j][1] * v[j][1]) + (v[j][2] * v[j][2] + v[j][3] * v[j][3]); }
    const float rstd = __builtin_amdgcn_rsqf(wave_sum(s2) * (1.f / D) + LN_EPS);
#pragma unroll
    for (int j = 0; j < 8; ++j) {
        const f32x4 gg = *((const f32x4*)gam + 64 * j + lane), bb = *((const f32x4*)bet + 64 * j + lane);
        f32x4 y = v[j] * rstd * gg + bb;
        if (F32OUT) *((f32x4*)orow + 64 * j + lane) = y;
        else { u32x2 w; w.x = pkh(y[0], y[1]); w.y = pkh(y[2], y[3]); *((u32x2*)orow + 64 * j + lane) = w; }
    }
}

__device__ __forceinline__ void phase0(const Params& p, LAS unsigned char* lds) {
    const int tid = threadIdx.x, lane = tid & 63, wave = tid >> 6, G = gridDim.x;
    const int gw = blockIdx.x * 8 + wave, NGW = G * 8;
    h16* h0 = (h16*)(p.ws + OFF_H0);
    {
        h16* FcT = (h16*)(p.ws + OFF_TAB); h16* F128 = FcT + 512 * 256; h16* G64 = F128 + 256 * 256;
        const int gt = blockIdx.x * 512 + tid, NT = G * 512;
        for (int i = gt; i < 512 * 256; i += NT) { const int nn = i >> 8, c = i & 255, cp = nn >> 1, ri = nn & 1; const float fr = (float)((c * cp) & 255) * (1.f / 256.f);
            FcT[i] = (h16)((ri ? -__builtin_amdgcn_sinf(fr) : __builtin_amdgcn_cosf(fr)) * 0.0625f); }
        for (int i = gt; i < 256 * 256; i += NT) { const int rho = i >> 8, kap = i & 255, ka = rho >> 1, rp = rho & 1, ri = kap >> 7, th = kap & 127; const float fr = (float)((ka * th) & 127) * (1.f / 128.f);
            const float cs = __builtin_amdgcn_cosf(fr), sn = __builtin_amdgcn_sinf(fr); const float v = rp == 0 ? (ri == 0 ? cs : sn) : (ri == 0 ? -sn : cs);
            F128[i] = (h16)(v * 0.08838834764831845f); }
        for (int i = gt; i < 64 * 128; i += NT) { const int kb = i >> 7, kk = i & 127, ri = kk >> 6, tl = kk & 63; const float fr = (float)((kb * tl) & 63) * (1.f / 64.f);
            G64[i] = (h16)((ri ? __builtin_amdgcn_sinf(fr) : __builtin_amdgcn_cosf(fr)) * 0.125f); }
    }
    for (int r = gw; r < T; r += NGW) ln_row<false>(p.x + (size_t)r * D, p.ln_emb_g, p.ln_emb_b, h0 + (size_t)r * D, lane);
    LAS float* scr = (LAS float*)(lds + wave * 8448);
    constexpr int I_IN = (D / 64) * (PW / 32), I_OUT = (D / 64) * (D / 32);
    for (int it = gw; it < I_IN + I_OUT; it += NGW) {
        if (it < I_IN) transpose_item(p.w_in, D, PW, (h16*)(p.ws + OFF_WIN), scr, it, lane, RmId());
        else transpose_item(p.w_out, D, D, (h16*)(p.ws + OFF_WOUT), scr, it - I_IN, lane, RmId());
    }
}

__device__ __forceinline__ void fa_tile(const Params& p, LAS unsigned char* lds, int tile) {
    const int tid = threadIdx.x, lane = tid & 63, w = __builtin_amdgcn_readfirstlane(tid >> 6), r = lane & 15, g = lane >> 4;
    const int t_lo = tile & 63, grp = tile >> 6;
    const h16* U = (const h16*)(p.ws + OFF_U) + 4 * UBLK;
    const h16* FcT = (const h16*)(p.ws + OFF_TAB); const h16* F128 = FcT + 512 * 256;
    h16* Wtw = (h16*)p.out;
    LAS unsigned char* ldsZ = lds + 67584;
#pragma unroll
    for (int i = 0; i < 8; ++i) { const int idx = tid + 512 * i, row = idx >> 5, ch = idx & 31;
        const u32x4 v = *(const u32x4*)(U + (size_t)(t_lo + 64 * row) * 1024 + grp * 256 + ch * 8);
        *(LAS u32x4*)(lds + row * 528 + ch * 16) = v; }
    h16x8 FA3[2][8];
#pragma unroll
    for (int mi = 0; mi < 2; ++mi)
#pragma unroll
        for (int ks = 0; ks < 8; ++ks) FA3[mi][ks] = *(const h16x8*)(F128 + (16 * (2 * w + mi) + r) * 256 + 32 * ks + 8 * g);
    __syncthreads();
    for (int cb = 0; cb < 4; ++cb) {
        {
            h16x8 Bf[8];
#pragma unroll
            for (int ks = 0; ks < 8; ++ks) Bf[ks] = *(const h16x8*)(FcT + (cb * 128 + 16 * w + r) * 256 + 32 * ks + 8 * g);
            f32x4 acc[8];
#pragma unroll
            for (int mt = 0; mt < 8; ++mt) acc[mt] = (f32x4){0.f, 0.f, 0.f, 0.f};
#pragma unroll
            for (int mt = 0; mt < 8; ++mt)
#pragma unroll
                for (int ks = 0; ks < 8; ++ks) { const h16x8 a = *(const LAS h16x8*)(lds + (16 * mt + r) * 528 + (32 * ks + 8 * g) * 2);
                    acc[mt] = __builtin_amdgcn_mfma_f32_16x16x32_f16(a, Bf[ks], acc[mt], 0, 0, 0); }
            const int n_l = 16 * w + r, zrow = (n_l >> 1) * 264 + (n_l & 1) * 128;
#pragma unroll
            for (int mt = 0; mt < 8; ++mt) { u32x2 o; o.x = pkh(acc[mt][0], acc[mt][1]); o.y = pkh(acc[mt][2], acc[mt][3]);
                *(LAS u32x2*)(ldsZ + (zrow + 16 * mt + 4 * g) * 2) = o; }
        }
        __syncthreads();
        {
            f32x4 acc3[2][4];
#pragma unroll
            for (int mi = 0; mi < 2; ++mi)
#pragma unroll
                for (int nt = 0; nt < 4; ++nt) acc3[mi][nt] = (f32x4){0.f, 0.f, 0.f, 0.f};
#pragma unroll
            for (int ks = 0; ks < 8; ++ks)
#pragma unroll
                for (int nt = 0; nt < 4; ++nt) { const h16x8 b = *(const LAS h16x8*)(ldsZ + ((16 * nt + r) * 264 + 32 * ks + 8 * g) * 2);
#pragma unroll
                    for (int mi = 0; mi < 2; ++mi) acc3[mi][nt] = __builtin_amdgcn_mfma_f32_16x16x32_f16(FA3[mi][ks], b, acc3[mi][nt], 0, 0, 0); }
#pragma unroll
            for (int mi = 0; mi < 2; ++mi)
#pragma unroll
                for (int pp = 0; pp < 2; ++pp) { const int k_a = 8 * (2 * w + mi) + 2 * g + pp; const float ang = (float)(t_lo * k_a) * (1.f / 8192.f);
                    const float wr_ = __builtin_amdgcn_cosf(ang), wi_ = -__builtin_amdgcn_sinf(ang);
                    h16* dst = Wtw + ((((size_t)t_lo * 128 + k_a) * 4 + grp) * 256 + cb * 64 + r) * 2;
#pragma unroll
                    for (int nt = 0; nt < 4; ++nt) { const float re = acc3[mi][nt][2 * pp], im = acc3[mi][nt][2 * pp + 1];
                        *(unsigned*)(dst + nt * 32) = pkh(re * wr_ - im * wi_, re * wi_ + im * wr_); } }
        }
        __syncthreads();
    }
}

__device__ __forceinline__ void fb_tile(const Params& p, LAS unsigned char* lds, int tile, const h16x8 (&Bg)[4][4]) {
    const int tid = threadIdx.x, lane = tid & 63, w = __builtin_amdgcn_readfirstlane(tid >> 6), r = lane & 15, g = lane >> 4;
    const int k_a = tile & 127, grp = tile >> 7;
    const h16* Wtw = (const h16*)p.out;
    h16* mix = (h16*)(p.ws + OFF_MIX);
    LAS h16* ldsW = (LAS h16*)lds;
#pragma unroll
    for (int i = 0; i < 8; ++i) { const int idx = tid + 512 * i, t_lo = idx >> 6, ch = idx & 63;
        const h16x8 v = *(const h16x8*)(Wtw + ((((size_t)t_lo * 128 + k_a) * 4 + grp) * 256 + 4 * ch) * 2);
#pragma unroll
        for (int q = 0; q < 4; ++q) { ldsW[(4 * ch + q) * 136 + t_lo] = v[2 * q]; ldsW[(4 * ch + q) * 136 + 64 + t_lo] = v[2 * q + 1]; } }
    __syncthreads();
    f32x4 acc[2][4];
#pragma unroll
    for (int mi = 0; mi < 2; ++mi)
#pragma unroll
        for (int nt = 0; nt < 4; ++nt) acc[mi][nt] = (f32x4){0.f, 0.f, 0.f, 0.f};
#pragma unroll
    for (int ks = 0; ks < 4; ++ks)
#pragma unroll
        for (int mi = 0; mi < 2; ++mi) { const h16x8 a = *(const LAS h16x8*)(ldsW + (16 * (2 * w + mi) + r) * 136 + 32 * ks + 8 * g);
#pragma unroll
            for (int nt = 0; nt < 4; ++nt) acc[mi][nt] = __builtin_amdgcn_mfma_f32_16x16x32_f16(a, Bg[nt][ks], acc[mi][nt], 0, 0, 0); }
#pragma unroll
    for (int mi = 0; mi < 2; ++mi)
#pragma unroll
        for (int nt = 0; nt < 4; ++nt) { const int tp = k_a + 128 * (16 * nt + r); u32x2 o; o.x = pkh(acc[mi][nt][0], acc[mi][nt][1]); o.y = pkh(acc[mi][nt][2], acc[mi][nt][3]);
            *(u32x2*)(mix + (size_t)tp * D + 1024 + grp * 256 + 16 * (2 * w + mi) + 4 * g) = o; }
    __syncthreads();
}

__device__ __forceinline__ void prep_item(const Params& p, LAS unsigned char* lds, int item) {
    const int tid = threadIdx.x, lane = tid & 63, w = __builtin_amdgcn_readfirstlane(tid >> 6), r = lane & 15, g = lane >> 4;
    const int n = item & 127, h = (item >> 7) & 7, d = item >> 10;
    const h16* ub = (const h16*)(p.ws + OFF_U);
    const h16* uq = ub, *uv = ub + UBLK, *uz = ub + (size_t)(2 + d) * UBLK;
    unsigned char* rec = p.ws + OFF_PQ + (size_t)item * REC_BYTES;
    h16* vfr = (h16*)((unsigned char*)p.out + 32 * MiB + (size_t)item * 16384);
    float* dec = (float*)(p.ws + OFF_DEC) + (size_t)item * 128;
    LAS unsigned short* Qb = (LAS unsigned short*)lds;
    LAS unsigned short* KIb = (LAS unsigned short*)(lds + 17408);
    LAS h16* Qh = (LAS h16*)(lds + 34816);
    LAS float* segtot = (LAS float*)(lds + 52224);
    const int k = tid & 127, seg = tid >> 7, ch = h * 128 + k;
    const float* lbl = d ? p.lbb : p.lbf;
    const float lb = __builtin_amdgcn_rcpf(1.0f + __expf(lbl[1024 + ch] - lbl[ch]));
    float bc[16], kk[16];
    float run = 0.f;
#pragma unroll
    for (int jj = 0; jj < 16; ++jj) { const int tau = 64 * n + 16 * seg + jj, t = d ? (T - 1 - tau) : tau;
        const float z = (float)uz[(size_t)t * 1024 + ch];
        const float sg = __builtin_amdgcn_rcpf(1.0f + __expf(-z));
        const float f = lb + (1.0f - lb) * sg;
        run += __logf(f); bc[jj] = run; kk[jj] = 1.0f - f; }
    segtot[seg * 128 + k] = run;
    __syncthreads();
    float pre = 0.f, tot = 0.f;
#pragma unroll
    for (int s = 0; s < 4; ++s) { const float v = segtot[s * 128 + k]; tot += v; if (s < seg) pre += v; }
    if (seg == 0) dec[k] = __expf(tot);
    {
        u32x4 ke[2]; u32x4 vv[2];
        float kef[16]; h16 vvh[16];
#pragma unroll
        for (int jj = 0; jj < 16; ++jj) { const int j = 16 * seg + jj, tau = 64 * n + j, t = d ? (T - 1 - tau) : tau;
            const float b = pre + bc[jj];
            const float q = (float)uq[(size_t)t * 1024 + ch];
            const float qd = q * __expf(b);
            Qb[j * 136 + k] = f2bf(qd); Qh[j * 136 + k] = (h16)qd;
            KIb[j * 136 + k] = f2bf(kk[jj] * __expf(-b));
            kef[jj] = kk[jj] * __expf(tot - b);
            vvh[jj] = uv[(size_t)t * 1024 + ch]; }
#pragma unroll
        for (int hh = 0; hh < 2; ++hh) { ke[hh].x = pkh(kef[8 * hh + 0], kef[8 * hh + 1]); ke[hh].y = pkh(kef[8 * hh + 2], kef[8 * hh + 3]); ke[hh].z = pkh(kef[8 * hh + 4], kef[8 * hh + 5]); ke[hh].w = pkh(kef[8 * hh + 6], kef[8 * hh + 7]);
            h16x8 t8;
#pragma unroll
            for (int e = 0; e < 8; ++e) t8[e] = vvh[8 * hh + e];
            vv[hh] = __builtin_bit_cast(u32x4, t8); }
        const int mt = k >> 4, ksp = seg >> 1;
#pragma unroll
        for (int hh = 0; hh < 2; ++hh) { const int lp = (2 * (seg & 1) + hh) * 16 + (k & 15); const size_t fo = ((size_t)(mt * 2 + ksp) * 64 + lp) * 16;
            *(u32x4*)(rec + 24576 + fo) = ke[hh];
            *(u32x4*)((unsigned char*)vfr + fo) = vv[hh]; }
    }
    __syncthreads();
#pragma unroll
    for (int i = 0; i < 4; ++i) { const int gi = tid + 512 * i, lp = gi & 63, jt = (gi >> 6) & 3, wq = gi >> 8, rr = lp & 15, gg = lp >> 4;
        const u32x2 v = *(const LAS u32x2*)(Qh + (16 * jt + rr) * 136 + 16 * wq + 4 * gg);
        *(u32x2*)(rec + 8192 + (size_t)gi * 8) = v; }
    {
        const int jt = w >> 1;
#pragma unroll
        for (int si = 0; si < 2; ++si) { const int st = 2 * (w & 1) + si;
            f32x4 a4 = (f32x4){0.f, 0.f, 0.f, 0.f};
            if (st <= jt) {
#pragma unroll
                for (int ks = 0; ks < 4; ++ks) { const s16x8 a = *(const LAS s16x8*)(KIb + (16 * st + r) * 136 + 32 * ks + 8 * g); const s16x8 b = *(const LAS s16x8*)(Qb + (16 * jt + r) * 136 + 32 * ks + 8 * g);
                    a4 = __builtin_amdgcn_mfma_f32_16x16x32_bf16(__builtin_bit_cast(__bf16 __attribute__((ext_vector_type(8))), a), __builtin_bit_cast(__bf16 __attribute__((ext_vector_type(8))), b), a4, 0, 0, 0); }
            }
            const int j = 16 * jt + r;
#pragma unroll
            for (int i = 0; i < 4; ++i) { const int s = 16 * st + 4 * g + i; if (s > j) a4[i] = 0.f; }
            u32x2 o; o.x = pkh(a4[0], a4[1]); o.y = pkh(a4[2], a4[3]);
            const int lp = (2 * (st & 1) + (g >> 1)) * 16 + r;
            *(u32x2*)(rec + ((size_t)(jt * 2 + (st >> 1)) * 64 + lp) * 16 + 8 * (g & 1)) = o; }
    }
    __syncthreads();
}

struct StepLd { h16x8 ke0, ke1, bv0, bv1, pf; h16x4 q[4]; f32x4 dec; };
__device__ __forceinline__ void scan_load(StepLd& L, const unsigned char* rec0, const unsigned char* vf0, const float* dec0, int n, int w, int lane, int vs) {
    n = n < 127 ? n : 127;
    const unsigned char* rec = rec0 + (size_t)n * REC_BYTES;
    L.pf = *(const h16x8*)(rec + ((size_t)((w & 3) * 2 + (w >> 2)) * 64 + lane) * 16);
#pragma unroll
    for (int jt = 0; jt < 4; ++jt) L.q[jt] = *(const h16x4*)(rec + 8192 + ((size_t)(w * 4 + jt) * 64 + lane) * 8);
    L.ke0 = *(const h16x8*)(rec + 24576 + ((size_t)(w * 2 + 0) * 64 + lane) * 16);
    L.ke1 = *(const h16x8*)(rec + 24576 + ((size_t)(w * 2 + 1) * 64 + lane) * 16);
    const unsigned char* vf = vf0 + (size_t)n * 16384;
    L.bv0 = *(const h16x8*)(vf + ((size_t)(vs * 2 + 0) * 64 + lane) * 16);
    L.bv1 = *(const h16x8*)(vf + ((size_t)(vs * 2 + 1) * 64 + lane) * 16);
    L.dec = *(const f32x4*)(dec0 + (size_t)n * 128 + 16 * w + 4 * (lane >> 4));
}
__device__ __forceinline__ void scan_step(const StepLd& L, f32x4& S, LAS unsigned char* lds, float* od, int n, int d, int w, int lane) {
    const h16x4 sb = __builtin_convertvector(S, h16x4);
    f32x4 o[4];
#pragma unroll
    for (int jt = 0; jt < 4; ++jt) o[jt] = __builtin_amdgcn_mfma_f32_16x16x16f16(L.q[jt], sb, (f32x4){0.f, 0.f, 0.f, 0.f}, 0, 0, 0);
    const h16x8 bvp = (w >> 2) ? L.bv1 : L.bv0;
#pragma unroll
    for (int jt = 0; jt < 4; ++jt) if (jt == (w & 3)) o[jt] = __builtin_amdgcn_mfma_f32_16x16x32_f16(L.pf, bvp, o[jt], 0, 0, 0);
    S = S * L.dec;
    S = __builtin_amdgcn_mfma_f32_16x16x32_f16(L.ke0, L.bv0, S, 0, 0, 0);
    S = __builtin_amdgcn_mfma_f32_16x16x32_f16(L.ke1, L.bv1, S, 0, 0, 0);
    LAS unsigned char* pb = lds + (n & 1) * 32768;
#pragma unroll
    for (int jt = 0; jt < 4; ++jt) *(LAS f32x4*)(pb + ((w * 4 + jt) * 64 + lane) * 16) = o[jt];
    __syncthreads();
    if (w < 4) {
        f32x4 tot = (f32x4){0.f, 0.f, 0.f, 0.f};
#pragma unroll
        for (int ww = 0; ww < 8; ++ww) tot += *(const LAS f32x4*)(pb + ((ww * 4 + w) * 64 + lane) * 16);
        const int r = lane & 15, g = lane >> 4;
#pragma unroll
        for (int i = 0; i < 4; ++i) { const int tau = 64 * n + 16 * w + 4 * g + i, t = d ? (T - 1 - tau) : tau; od[(size_t)t * 1024 + r] = tot[i]; }
    }
}
__device__ __forceinline__ void scan_job(const Params& p, LAS unsigned char* lds, int job) {
    const int tid = threadIdx.x, lane = tid & 63, w = __builtin_amdgcn_readfirstlane(tid >> 6);
    const int vs = job & 7, h = (job >> 3) & 7, d = job >> 6;
    const size_t item0 = (size_t)(d * 8 + h) * 128;
    const unsigned char* rec0 = p.ws + OFF_PQ + item0 * REC_BYTES;
    const unsigned char* vf0 = (const unsigned char*)p.out + 32 * MiB + item0 * 16384;
    const float* dec0 = (const float*)(p.ws + OFF_DEC) + item0 * 128;
    float* od = (float*)(p.ws + OFF_ODIR) + (size_t)d * T * 1024 + h * 128 + vs * 16;
    f32x4 S = (f32x4){0.f, 0.f, 0.f, 0.f};
    StepLd b0, b1, b2, b3;
    scan_load(b0, rec0, vf0, dec0, 0, w, lane, vs); scan_load(b1, rec0, vf0, dec0, 1, w, lane, vs); scan_load(b2, rec0, vf0, dec0, 2, w, lane, vs);
    for (int n = 0; n < 128; n += 4) {
        scan_load(b3, rec0, vf0, dec0, n + 3, w, lane, vs); scan_step(b0, S, lds, od, n, d, w, lane);
        scan_load(b0, rec0, vf0, dec0, n + 4, w, lane, vs); scan_step(b1, S, lds, od, n + 1, d, w, lane);
        scan_load(b1, rec0, vf0, dec0, n + 5, w, lane, vs); scan_step(b2, S, lds, od, n + 2, d, w, lane);
        scan_load(b2, rec0, vf0, dec0, n + 6, w, lane, vs); scan_step(b3, S, lds, od, n + 3, d, w, lane);
    }
    __syncthreads();
}

__device__ __forceinline__ void phase4(const Params& p, LAS unsigned char* lds) {
    const int tid = threadIdx.x, lane = tid & 63, wave = tid >> 6, G = gridDim.x;
    const int gw = blockIdx.x * 8 + wave, NGW = G * 8;
    const float* of = (const float*)(p.ws + OFF_ODIR); const float* ob = of + (size_t)T * 1024;
    const h16* ug = (const h16*)(p.ws + OFF_U) + 5 * UBLK;
    h16* mix = (h16*)(p.ws + OFF_MIX);
    const f32x2 gn = *((const f32x2*)p.g_norm + lane);
    for (int it = gw; it < T * 8; it += NGW) { const int t = it >> 3, h = it & 7; const size_t o = (size_t)t * 1024 + h * 128 + 2 * lane;
        const f32x2 a = *(const f32x2*)(of + o), b = *(const f32x2*)(ob + o); const float o0 = a.x + b.x, o1 = a.y + b.y;
        const float ss = wave_sum(o0 * o0 + o1 * o1); const float rs = __builtin_amdgcn_rsqf(ss * (1.f / 128.f) + RMS_EPS);
        const h16x2 gv = *(const h16x2*)(ug + o);
        *(unsigned*)(mix + (size_t)t * D + h * 128 + 2 * lane) = pkh(o0 * rs * gn.x * (float)gv.x, o1 * rs * gn.y * (float)gv.y); }
    LAS float* scr = (LAS float*)(lds + wave * 8448);
    constexpr int I_G = (D / 64) * (FF / 32), I_D = (FF / 64) * (D / 32);
    for (int it = gw; it < 2 * I_G + I_D; it += NGW) {
        if (it < I_G) transpose_item(p.w_gate, D, FF, (h16*)(p.ws + OFF_WGU), scr, it, lane, RmGate());
        else if (it < 2 * I_G) transpose_item(p.w_up, D, FF, (h16*)(p.ws + OFF_WGU), scr, it - I_G, lane, RmUp());
        else transpose_item(p.w_down, FF, D, (h16*)(p.ws + OFF_WD), scr, it - 2 * I_G, lane, RmId());
    }
}

__global__ void __launch_bounds__(512, 2) fwd_megakernel(Params p) {
    extern __shared__ __attribute__((aligned(16))) unsigned char shm[];
    LAS unsigned char* lds = (LAS unsigned char*)shm;
    const int G = gridDim.x, bid = blockIdx.x, tid = threadIdx.x, lane = tid & 63, wave = tid >> 6;
    const int gw = bid * 8 + wave, NGW = G * 8;
#define RUN(ph) (p.ph_lo <= (ph) && (ph) < p.ph_hi)
#define SYNC(ph) do { if (p.ph_lo < (ph) && (ph) < p.ph_hi) cg::this_grid().sync(); } while (0)
    if (RUN(0)) phase0(p, lds);
    SYNC(1);
    if (RUN(1)) { pg8::Gemm g{(const h16*)(p.ws + OFF_H0), (const h16*)(p.ws + OFF_WIN), T, PW, D}; pg8::StaticOrder S; S.init(T, PW, G, bid);
        pg8::EpiU E{(h16*)(p.ws + OFF_U)}; pg8::gemm_phase(lds, g, S, E); }
    SYNC(2);
    if (RUN(2)) {
        for (int tile = bid; tile < 256; tile += G) fa_tile(p, lds, tile);
        for (int item = bid; item < 2048; item += G) prep_item(p, lds, item);
    }
    SYNC(3);
    if (RUN(3)) {
        for (int job = bid; job < 128; job += G) scan_job(p, lds, job);
        const int fb0 = G > 128 ? 128 : 0, nfb = G - fb0;
        if (bid >= fb0) {
            const int r = lane & 15, g = lane >> 4;
            const h16* G64 = (const h16*)(p.ws + OFF_TAB) + 512 * 256 + 256 * 256;
            h16x8 Bg[4][4];
#pragma unroll
            for (int nt = 0; nt < 4; ++nt)
#pragma unroll
                for (int ks = 0; ks < 4; ++ks) Bg[nt][ks] = *(const h16x8*)(G64 + (16 * nt + r) * 128 + 32 * ks + 8 * g);
            for (int tile = bid - fb0; tile < 512; tile += nfb) fb_tile(p, lds, tile, Bg);
        }
    }
    SYNC(4);
    if (RUN(4)) phase4(p, lds);
    SYNC(5);
    if (RUN(5)) { pg8::Gemm g{(const h16*)(p.ws + OFF_MIX), (const h16*)(p.ws + OFF_WOUT), T, D, D}; pg8::StaticOrder S; S.init(T, D, G, bid);
        pg8::EpiRes E{p.out, (const h16*)(p.ws + OFF_H0)}; pg8::gemm_phase(lds, g, S, E); }
    SYNC(6);
    if (RUN(6)) { h16* h1 = (h16*)(p.ws + OFF_H0);
        for (int r = gw; r < T; r += NGW) ln_row<false>(p.out + (size_t)r * D, p.ln1_g, p.ln1_b, h1 + (size_t)r * D, lane); }
    SYNC(7);
    if (RUN(7)) { pg8::Gemm g{(const h16*)(p.ws + OFF_H0), (const h16*)(p.ws + OFF_WGU), T, 2 * FF, D}; pg8::StaticOrder S; S.init(T, 2 * FF, G, bid);
        pg8::EpiGlu E{(h16*)(p.ws + OFF_ACT)}; pg8::gemm_phase(lds, g, S, E); }
    SYNC(8);
    if (RUN(8)) { pg8::Gemm g{(const h16*)(p.ws + OFF_ACT), (const h16*)(p.ws + OFF_WD), T, D, FF}; pg8::StaticOrder S; S.init(T, D, G, bid);
        pg8::EpiRes E{p.out, (const h16*)(p.ws + OFF_H0)}; pg8::gemm_phase(lds, g, S, E); }
    SYNC(9);
    if (RUN(9)) { for (int r = gw; r < T; r += NGW) ln_row<true>(p.out + (size_t)r * D, p.ln2_g, p.ln2_b, p.out + (size_t)r * D, lane); }
}

extern "C" void kernel_launch(void* const* d_in, const int* in_sizes, int n_in, void* d_out, int out_size, void* d_ws, size_t ws_size, hipStream_t stream) {
    static int grid = 0;
    if (grid == 0) {
        if (n_in != 15 || in_sizes[0] != T * D || out_size != T * D || ws_size < WS_NEED) { fprintf(stderr, "kernel_launch: unexpected shapes (n_in %d in0 %d out %d ws %zu)\n", n_in, n_in > 0 ? in_sizes[0] : -1, out_size, ws_size); grid = -1; return; }
        int dev = 0, cus = 0, per_cu = 0;
        hipGetDevice(&dev); hipDeviceGetAttribute(&cus, hipDeviceAttributeMultiprocessorCount, dev);
        if (hipFuncSetAttribute((const void*)fwd_megakernel, hipFuncAttributeMaxDynamicSharedMemorySize, LDS_BYTES) != hipSuccess) { fprintf(stderr, "kernel_launch: hipFuncSetAttribute failed\n"); grid = -1; return; }
        if (hipOccupancyMaxActiveBlocksPerMultiprocessor(&per_cu, (const void*)fwd_megakernel, 512, LDS_BYTES) != hipSuccess || per_cu < 1) { fprintf(stderr, "kernel_launch: occupancy query gave %d\n", per_cu); per_cu = 1; }
        (void)hipGetLastError();
        grid = cus * 1;
        if (grid > 256) grid = 256;
    }
    if (grid < 0) return;
    Params p{};
    p.x = (const float*)d_in[0]; p.ln_emb_g = (const float*)d_in[1]; p.ln_emb_b = (const float*)d_in[2]; p.w_in = (const float*)d_in[3];
    p.lbf = (const float*)d_in[4]; p.lbb = (const float*)d_in[5]; p.g_norm = (const float*)d_in[6]; p.w_out = (const float*)d_in[7];
    p.ln1_g = (const float*)d_in[8]; p.ln1_b = (const float*)d_in[9]; p.w_gate = (const float*)d_in[10]; p.w_up = (const float*)d_in[11];
    p.w_down = (const float*)d_in[12]; p.ln2_g = (const float*)d_in[13]; p.ln2_b = (const float*)d_in[14];
    p.out = (float*)d_out; p.ws = (unsigned char*)d_ws;
#if N_LAUNCH_MODE == 1
    p.ph_lo = 0; p.ph_hi = 10;
    void* args[] = {&p};
    hipError_t e = hipLaunchCooperativeKernel((const void*)fwd_megakernel, dim3(grid), dim3(512), args, LDS_BYTES, stream);
    if (e != hipSuccess) fprintf(stderr, "cooperative launch failed: %s (grid %d)\n", hipGetErrorString(e), grid);
#else
    for (int ph = 0; ph < 10; ++ph) { p.ph_lo = ph; p.ph_hi = ph + 1; hipLaunchKernelGGL(fwd_megakernel, dim3(grid), dim3(512), LDS_BYTES, stream, p); }
#endif
}
```

```cpp
#include <hip/hip_runtime.h>
#include <hip/hip_cooperative_groups.h>
#include <cstdio>
#include <cstdint>
namespace cg = cooperative_groups;

#ifndef N_LAUNCH_MODE
#define N_LAUNCH_MODE 1
#endif

#define LAS __attribute__((address_space(3)))
typedef _Float16 h16;
typedef _Float16 h16x8 __attribute__((ext_vector_type(8)));
typedef _Float16 h16x4 __attribute__((ext_vector_type(4)));
typedef _Float16 h16x2 __attribute__((ext_vector_type(2)));
typedef short s16x8 __attribute__((ext_vector_type(8)));
typedef float f32x4 __attribute__((ext_vector_type(4)));
typedef float f32x2 __attribute__((ext_vector_type(2)));
typedef unsigned u32x4 __attribute__((ext_vector_type(4)));
typedef unsigned u32x2 __attribute__((ext_vector_type(2)));

constexpr int T = 8192, D = 2048, PW = 6144, FF = 5632, HW = 1024;
constexpr float ALPHA = 1.189207115002721f;
constexpr float LN_EPS = 1e-5f, RMS_EPS = 1e-6f;
constexpr size_t MiB = 1ull << 20;
constexpr size_t OFF_H0 = 0;
constexpr size_t OFF_WOUT = 32 * MiB;
constexpr size_t OFF_WIN = 40 * MiB;
constexpr size_t OFF_U = 64 * MiB;
constexpr size_t OFF_PQ = 160 * MiB;
constexpr size_t OFF_DEC = 240 * MiB;
constexpr size_t OFF_TAB = 241 * MiB;
constexpr size_t OFF_ODIR = 40 * MiB;
constexpr size_t OFF_MIX = 104 * MiB;
constexpr size_t OFF_WGU = 160 * MiB;
constexpr size_t OFF_WD = 204 * MiB;
constexpr size_t OFF_ACT = 40 * MiB;
constexpr size_t WS_NEED = 242 * MiB;
constexpr size_t UBLK = (size_t)T * 1024;
constexpr int REC_BYTES = 40960;
constexpr int LDS_BYTES = 131072;

struct Params {
    const float *x, *ln_emb_g, *ln_emb_b, *w_in, *lbf, *lbb, *g_norm, *w_out, *ln1_g, *ln1_b, *w_gate, *w_up, *w_down, *ln2_g, *ln2_b;
    float* out; unsigned char* ws; int ph_lo, ph_hi;
};

__device__ __forceinline__ float wave_sum(float v) {
#pragma unroll
    for (int o = 1; o < 64; o <<= 1) v += __shfl_xor(v, o);
    return v;
}
__device__ __forceinline__ float silu_f(float x) { return x * __builtin_amdgcn_rcpf(1.0f + __expf(-x)); }
__device__ __forceinline__ unsigned short f2bf(float f) { unsigned u = __float_as_uint(f); u += 0x7FFFu + ((u >> 16) & 1u); return (unsigned short)(u >> 16); }
__device__ __forceinline__ unsigned pkh(float a, float b) { h16x2 v; v.x = (h16)a; v.y = (h16)b; return __builtin_bit_cast(unsigned, v); }
#define LDS_WAIT() asm volatile("s_waitcnt lgkmcnt(0)" ::: "memory")

namespace pg8 {
constexpr int BM = 256, BK = 64, HALF = 128, HTB = HALF * BK * 2, STAGE_BYTES = 8 * HTB, NXCD = 8, WGM = 8;
__device__ __forceinline__ int lds_byte(int r, int c) { const int st = (r >> 4) * 2 + (c >> 5), rr = r & 15, cc = c & 31, ob = rr * 64 + cc * 2; return st * 1024 + (ob ^ (((ob >> 9) & 1) << 5)); }
__device__ __forceinline__ void stage_rc(int b, int& R, int& C) { const int st = b / 1024, sb = b % 1024, swz = sb ^ (((sb >> 9) & 1) << 5); R = (st >> 1) * 16 + swz / 64; C = (st & 1) * 32 + (swz % 64) / 2; }
__device__ __forceinline__ int perm32(int rho) { const int n = rho >> 4, i = rho & 15; return 8 * (i >> 2) + 4 * n + (i & 3); }
struct Unit { int pm, pn; };
struct Gemm { const h16* A; const h16* Bt; int M, N, K; };
struct StaticOrder {
    int nM, nN, nwg, G, c;
    __device__ void init(int M, int N, int G_, int c_) { nM = M / BM; nN = N / BM; nwg = nM * nN; G = G_; c = c_; }
    __device__ bool next(int i, Unit& u) const {
        const long L = (long)i * G + c; if (L >= nwg) return false;
        int wgid = (int)L; { const int q = nwg / NXCD, r = nwg % NXCD, xcd = wgid % NXCD, off = wgid / NXCD; wgid = (xcd < r ? xcd * (q + 1) : r * (q + 1) + (xcd - r) * q) + off; }
        const int nig = WGM * nN, gid = wgid / nig, fm = gid * WGM, gsz = (nM - fm) < WGM ? (nM - fm) : WGM;
        u.pm = fm + ((wgid % nig) % gsz); u.pn = (wgid % nig) / gsz; return true;
    }
};

template <class Epi>
__device__ __forceinline__ void gemm_phase(LAS unsigned char* lds, const Gemm g, const StaticOrder& S, const Epi& E) {
    const int tid = threadIdx.x, wid = __builtin_amdgcn_readfirstlane(tid >> 6), lane = tid & 63, wr = wid >> 2, wc = wid & 3, fr = lane & 15, fq = lane >> 4;
    const int K = g.K, nt = K / BK;
    unsigned voffA[2], voffB[2];
#pragma unroll
    for (int i = 0; i < 2; ++i) { int R, C; stage_rc(tid * 16 + i * 8192, R, C); const int Rb = Epi::PERM ? ((R & ~31) + perm32(R & 31)) : R;
        voffA[i] = (unsigned)(R * K + C) * 2u; voffB[i] = (unsigned)(Rb * K + C) * 2u; }
    const size_t kstep = (size_t)(BK * 2);
    const size_t hstep = (size_t)HALF * K * 2;
    const size_t tstep = 2 * hstep;
    const unsigned ldsw = (unsigned)wid * 1024u;
    const int aoff = lds_byte(wr * 64 + fr, fq * 8), boff = lds_byte(wc * 32 + fr, fq * 8);
#define PG8_SA(b, h) (((b) * 2 + (h)) * HTB)
#define PG8_SB(b, h) ((4 + (b) * 2 + (h)) * HTB)
#define PG8_STAGE(bufoff, gbase, voff) do { _Pragma("unroll") for (int _i = 0; _i < 2; ++_i) \
        __builtin_amdgcn_global_load_lds((const unsigned*)((const char*)(gbase) + (voff)[_i]), (LAS unsigned*)(lds + (bufoff) + ldsw + _i * 8192), 16, 0, 0); } while (0)
#define PG8_LDA(dst, b, h) do { _Pragma("unroll") for (int m = 0; m < 4; ++m) _Pragma("unroll") for (int k = 0; k < 2; ++k) dst[m][k] = *(const LAS h16x8*)(lds + PG8_SA(b, h) + aoff + m * 2048 + k * 1024); } while (0)
#define PG8_LDB(dst, b, h) do { _Pragma("unroll") for (int n = 0; n < 2; ++n) _Pragma("unroll") for (int k = 0; k < 2; ++k) dst[n][k] = *(const LAS h16x8*)(lds + PG8_SB(b, h) + boff + n * 2048 + k * 1024); } while (0)
#define PG8_MMA(ai, bj, At, Bt) do { __builtin_amdgcn_s_setprio(1); _Pragma("unroll") for (int m = 0; m < 4; ++m) _Pragma("unroll") for (int n = 0; n < 2; ++n) _Pragma("unroll") for (int k = 0; k < 2; ++k) \
        acc[ai][bj][m][n] = __builtin_amdgcn_mfma_f32_16x16x32_f16(Bt[n][k], At[m][k], acc[ai][bj][m][n], 0, 0, 0); __builtin_amdgcn_s_setprio(0); } while (0)
#define PG8_WAIT_V(n) asm volatile("s_waitcnt vmcnt(" #n ")" ::: "memory")
#define PG8_WAIT_L(n) asm volatile("s_waitcnt lgkmcnt(" #n ")" ::: "memory")
#define PG8_BAR __builtin_amdgcn_s_barrier()
#define PG8_SCHED __builtin_amdgcn_sched_barrier(0)
    Unit cur, nxt; int ui = 0;
    if (!S.next(0, cur)) return;
    f32x4 acc[2][2][4][2];
#pragma unroll
    for (int a = 0; a < 2; ++a)
#pragma unroll
        for (int b = 0; b < 2; ++b)
#pragma unroll
            for (int m = 0; m < 4; ++m)
#pragma unroll
                for (int n = 0; n < 2; ++n) acc[a][b][m][n] = (f32x4){0.f, 0.f, 0.f, 0.f};
    h16x8 At[4][2], B0[2][2], B1[2][2];
    const char* cA = (const char*)g.A + (size_t)cur.pm * tstep; const char* cB = (const char*)g.Bt + (size_t)cur.pn * tstep;
    PG8_STAGE(PG8_SB(0, 0), cB, voffB); PG8_STAGE(PG8_SB(0, 1), cB + hstep, voffB); PG8_STAGE(PG8_SA(0, 0), cA, voffA); PG8_STAGE(PG8_SA(0, 1), cA + hstep, voffA);
    if (wr == 1) PG8_BAR;
    PG8_WAIT_V(2); PG8_BAR;
    PG8_STAGE(PG8_SB(1, 0), cB + kstep, voffB); PG8_STAGE(PG8_SA(1, 0), cA + kstep, voffA); PG8_STAGE(PG8_SB(1, 1), cB + hstep + kstep, voffB);
    PG8_WAIT_V(6); PG8_BAR;
    for (;;) {
        const bool has_next = S.next(ui + 1, nxt);
        const char* nA = has_next ? (const char*)g.A + (size_t)nxt.pm * tstep : cA; const char* nB = has_next ? (const char*)g.Bt + (size_t)nxt.pn * tstep : cB;
        for (int t = 0; t < nt; t += 2) {
            const bool last = (t == nt - 2);
            const char* a1 = cA + (size_t)(t + 1) * kstep;
            const char* a2 = last ? nA : cA + (size_t)(t + 2) * kstep; const char* b2 = last ? nB : cB + (size_t)(t + 2) * kstep;
            const char* a3 = a2 + kstep; const char* b3 = b2 + kstep;
            PG8_LDB(B0, 0, 0); PG8_LDB(B1, 0, 1); PG8_SCHED; PG8_LDA(At, 0, 0); PG8_STAGE(PG8_SA(1, 1), a1 + hstep, voffA);
            PG8_WAIT_V(8); PG8_WAIT_L(0); PG8_BAR; PG8_MMA(0, 0, At, B0); PG8_MMA(0, 1, At, B1); PG8_BAR; PG8_SCHED;
            PG8_LDA(At, 0, 1); PG8_STAGE(PG8_SB(0, 0), b2, voffB); PG8_STAGE(PG8_SB(0, 1), b2 + hstep, voffB); PG8_STAGE(PG8_SA(0, 0), a2, voffA);
            PG8_WAIT_V(8); PG8_WAIT_L(0); PG8_BAR; PG8_MMA(1, 0, At, B0); PG8_MMA(1, 1, At, B1); PG8_BAR; PG8_SCHED;
            PG8_LDB(B0, 1, 0); PG8_LDB(B1, 1, 1); PG8_SCHED; PG8_LDA(At, 1, 0); PG8_STAGE(PG8_SA(0, 1), a2 + hstep, voffA);
            PG8_WAIT_V(8); PG8_WAIT_L(0); PG8_BAR; PG8_MMA(0, 0, At, B0); PG8_MMA(0, 1, At, B1); PG8_BAR; PG8_SCHED;
            PG8_LDA(At, 1, 1); PG8_STAGE(PG8_SB(1, 0), b3, voffB); PG8_STAGE(PG8_SB(1, 1), b3 + hstep, voffB); PG8_STAGE(PG8_SA(1, 0), a3, voffA);
            PG8_WAIT_V(8); PG8_WAIT_L(0); PG8_BAR; PG8_MMA(1, 0, At, B0); PG8_MMA(1, 1, At, B1); PG8_BAR; PG8_SCHED;
        }
        if (wr == 0) PG8_BAR;
        E(acc, cur, wr, wc, fr, fq);
        if (!has_next) break;
#pragma unroll
        for (int a = 0; a < 2; ++a)
#pragma unroll
            for (int b = 0; b < 2; ++b)
#pragma unroll
                for (int m = 0; m < 4; ++m)
#pragma unroll
                    for (int n = 0; n < 2; ++n) acc[a][b][m][n] = (f32x4){0.f, 0.f, 0.f, 0.f};
        cur = nxt; cA = nA; cB = nB; ++ui;
        if (wr == 1) PG8_BAR;
    }
    PG8_WAIT_V(0);
    PG8_BAR;
#undef PG8_SA
#undef PG8_SB
#undef PG8_STAGE
#undef PG8_LDA
#undef PG8_LDB
#undef PG8_MMA
#undef PG8_WAIT_V
#undef PG8_WAIT_L
#undef PG8_BAR
#undef PG8_SCHED
}

struct EpiU {
    static constexpr bool PERM = true;
    h16* ubase;
    __device__ __forceinline__ void operator()(const f32x4 (&acc)[2][2][4][2], const Unit& u, int wr, int wc, int fr, int fq) const {
        const int row0 = u.pm * BM + wr * 64 + fr; int colt = u.pn * BM; const int blk = colt >> 10; colt &= 1023;
        const int dblk = blk == 4 ? 5 : (blk == 5 ? 4 : blk);
        h16* base = ubase + (size_t)dblk * UBLK; const bool act = (blk == 0) || (blk == 4);
        const int col0 = colt + wc * 32 + 8 * fq;
#pragma unroll
        for (int ai = 0; ai < 2; ++ai)
#pragma unroll
            for (int m = 0; m < 4; ++m) { h16* rowp = base + (size_t)(row0 + ai * HALF + m * 16) * 1024 + col0;
#pragma unroll
                for (int bj = 0; bj < 2; ++bj) { f32x4 v0 = acc[ai][bj][m][0], v1 = acc[ai][bj][m][1];
                    if (act) {
#pragma unroll
                        for (int j = 0; j < 4; ++j) { v0[j] = silu_f(v0[j]); v1[j] = silu_f(v1[j]); } }
                    u32x4 w; w.x = pkh(v0[0], v0[1]); w.y = pkh(v0[2], v0[3]); w.z = pkh(v1[0], v1[1]); w.w = pkh(v1[2], v1[3]);
                    *(u32x4*)(rowp + bj * HALF) = w; } }
    }
};
struct EpiRes {
    static constexpr bool PERM = false;
    float* Y; const h16* H;
    __device__ __forceinline__ void operator()(const f32x4 (&acc)[2][2][4][2], const Unit& u, int wr, int wc, int fr, int fq) const {
        const int row0 = u.pm * BM + wr * 64 + fr, col0 = u.pn * BM + wc * 32 + 4 * fq;
#pragma unroll
        for (int ai = 0; ai < 2; ++ai) {
            h16x4 hv[4][2][2];
#pragma unroll
            for (int m = 0; m < 4; ++m)
#pragma unroll
                for (int bj = 0; bj < 2; ++bj)
#pragma unroll
                    for (int n = 0; n < 2; ++n) hv[m][bj][n] = *(const h16x4*)(H + (size_t)(row0 + ai * HALF + m * 16) * D + col0 + bj * HALF + n * 16);
#pragma unroll
            for (int m = 0; m < 4; ++m)
#pragma unroll
                for (int bj = 0; bj < 2; ++bj)
#pragma unroll
                    for (int n = 0; n < 2; ++n) { f32x4 y = acc[ai][bj][m][n]; const h16x4 h4 = hv[m][bj][n];
                        y[0] += ALPHA * (float)h4[0]; y[1] += ALPHA * (float)h4[1]; y[2] += ALPHA * (float)h4[2]; y[3] += ALPHA * (float)h4[3];
                        *(f32x4*)(Y + (size_t)(row0 + ai * HALF + m * 16) * D + col0 + bj * HALF + n * 16) = y; }
        }
    }
};
struct EpiGlu {
    static constexpr bool PERM = true;
    h16* O;
    __device__ __forceinline__ void operator()(const f32x4 (&acc)[2][2][4][2], const Unit& u, int wr, int wc, int fr, int fq) const {
        const int row0 = u.pm * BM + wr * 64 + fr, col0 = u.pn * HALF + wc * 32 + 8 * fq;
#pragma unroll
        for (int ai = 0; ai < 2; ++ai)
#pragma unroll
            for (int m = 0; m < 4; ++m) { h16* rowp = O + (size_t)(row0 + ai * HALF + m * 16) * FF + col0;
                const f32x4 g0 = acc[ai][0][m][0], g1 = acc[ai][0][m][1], u0 = acc[ai][1][m][0], u1 = acc[ai][1][m][1];
                float r[8];
#pragma unroll
                for (int j = 0; j < 4; ++j) { r[j] = silu_f(g0[j]) * u0[j]; r[4 + j] = silu_f(g1[j]) * u1[j]; }
                u32x4 w; w.x = pkh(r[0], r[1]); w.y = pkh(r[2], r[3]); w.z = pkh(r[4], r[5]); w.w = pkh(r[6], r[7]);
                *(u32x4*)rowp = w; }
    }
};
}

template <class RM>
__device__ __forceinline__ void transpose_item(const float* W, int K, int N, h16* WT, LAS float* scr, int item, int lane, RM rm) {
    const int nblk = N / 32, kb = item / nblk, nb = item % nblk, k0 = 64 * kb, n0 = 32 * nb;
    f32x4 v[8];
#pragma unroll
    for (int i = 0; i < 8; ++i) v[i] = *(const f32x4*)(W + (size_t)(k0 + (lane >> 3) + 8 * i) * N + n0 + 4 * (lane & 7));
#pragma unroll
    for (int i = 0; i < 8; ++i) { LAS float* d = scr + ((lane >> 3) + 8 * i) * 33 + 4 * (lane & 7); d[0] = v[i][0]; d[1] = v[i][1]; d[2] = v[i][2]; d[3] = v[i][3]; }
    LDS_WAIT();
    const int c = lane & 7;
#pragma unroll
    for (int j = 0; j < 4; ++j) { const int n = (lane >> 3) + 8 * j; const LAS float* s = scr + (8 * c) * 33 + n;
        u32x4 o; o.x = pkh(s[0 * 33], s[1 * 33]); o.y = pkh(s[2 * 33], s[3 * 33]); o.z = pkh(s[4 * 33], s[5 * 33]); o.w = pkh(s[6 * 33], s[7 * 33]);
        *(u32x4*)(WT + (size_t)rm(n0 + n) * K + k0 + 8 * c) = o; }
    LDS_WAIT();
}
struct RmId { __device__ __forceinline__ int operator()(int n) const { return n; } };
struct RmGate { __device__ __forceinline__ int operator()(int n) const { return (n >> 7) * 256 + (n & 127); } };
struct RmUp { __device__ __forceinline__ int operator()(int n) const { return (n >> 7) * 256 + 128 + (n & 127); } };

struct LnAff { f32x4 g[8], b[8]; };
__device__ __forceinline__ void ln_load_aff(LnAff& A, const float* gam, const float* bet, int lane) {
#pragma unroll
    for (int j = 0; j < 8; ++j) { A.g[j] = *((const f32x4*)gam + 64 * j + lane); A.b[j] = *((const f32x4*)bet + 64 * j + lane); }
}
template <bool F32OUT>
__device__ __forceinline__ void ln_row(const float* xrow, const LnAff& A, void* orow, int lane) {
    const f32x4* xr = (const f32x4*)xrow + lane;
    f32x4 v[8]; float s = 0.f;
#pragma unroll
    for (int j = 0; j < 8; ++j) { v[j] = xr[64 * j]; s += (v[j][0] + v[j][1]) + (v[j][2] + v[j][3]); }
    const float mean = wave_sum(s) * (1.f / D); float s2 = 0.f;
#pragma unroll
    for (int j = 0; j < 8; ++j) { v[j] = v[j] - mean; s2 += (v[j][0] * v[j][0] + v[j][1] * v[j][1]) + (v[j][2] * v[j][2] + v[j][3] * v[j][3]); }
    const float rstd = __builtin_amdgcn_rsqf(wave_sum(s2) * (1.f / D) + LN_EPS);
#pragma unroll
    for (int j = 0; j < 8; ++j) {
        f32x4 y = v[j] * rstd * A.g[j] + A.b[j];
        if (F32OUT) *((f32x4*)orow + 64 * j + lane) = y;
        else { u32x2 w; w.x = pkh(y[0], y[1]); w.y = pkh(y[2], y[3]); *((u32x2*)orow + 64 * j + lane) = w; }
    }
}

__device__ __forceinline__ void phase0(const Params& p, LAS unsigned char* lds) {
    const int tid = threadIdx.x, lane = tid & 63, wave = tid >> 6, G = gridDim.x;
    const int gw = blockIdx.x * 8 + wave, NGW = G * 8;
    h16* h0 = (h16*)(p.ws + OFF_H0);
    {
        h16* FcT = (h16*)(p.ws + OFF_TAB); h16* F128 = FcT + 512 * 256; h16* G64 = F128 + 256 * 256;
        const int gt = blockIdx.x * 512 + tid, NT = G * 512;
        for (int i = gt; i < 512 * 256; i += NT) { const int nn = i >> 8, c = i & 255, cp = nn >> 1, ri = nn & 1; const float fr = (float)((c * cp) & 255) * (1.f / 256.f);
            FcT[i] = (h16)((ri ? -__builtin_amdgcn_sinf(fr) : __builtin_amdgcn_cosf(fr)) * 0.0625f); }
        for (int i = gt; i < 256 * 256; i += NT) { const int rho = i >> 8, kap = i & 255, ka = rho >> 1, rp = rho & 1, ri = kap >> 7, th = kap & 127; const float fr = (float)((ka * th) & 127) * (1.f / 128.f);
            const float cs = __builtin_amdgcn_cosf(fr), sn = __builtin_amdgcn_sinf(fr); const float v = rp == 0 ? (ri == 0 ? cs : sn) : (ri == 0 ? -sn : cs);
            F128[i] = (h16)(v * 0.08838834764831845f); }
        for (int i = gt; i < 64 * 128; i += NT) { const int kb = i >> 7, kk = i & 127, ri = kk >> 6, tl = kk & 63; const float fr = (float)((kb * tl) & 63) * (1.f / 64.f);
            G64[i] = (h16)((ri ? __builtin_amdgcn_sinf(fr) : __builtin_amdgcn_cosf(fr)) * 0.125f); }
    }
    { LnAff A; ln_load_aff(A, p.ln_emb_g, p.ln_emb_b, lane);
      for (int r = gw; r < T; r += NGW) ln_row<false>(p.x + (size_t)r * D, A, h0 + (size_t)r * D, lane); }
    LAS float* scr = (LAS float*)(lds + wave * 8448);
    constexpr int I_IN = (D / 64) * (PW / 32), I_OUT = (D / 64) * (D / 32);
    for (int it = gw; it < I_IN + I_OUT; it += NGW) {
        if (it < I_IN) transpose_item(p.w_in, D, PW, (h16*)(p.ws + OFF_WIN), scr, it, lane, RmId());
        else transpose_item(p.w_out, D, D, (h16*)(p.ws + OFF_WOUT), scr, it - I_IN, lane, RmId());
    }
}

__device__ __forceinline__ void fa_tile(const Params& p, LAS unsigned char* lds, int tile) {
    const int tid = threadIdx.x, lane = tid & 63, w = __builtin_amdgcn_readfirstlane(tid >> 6), r = lane & 15, g = lane >> 4;
    const int t_lo = tile & 63, grp = tile >> 6;
    const h16* U = (const h16*)(p.ws + OFF_U) + 4 * UBLK;
    const h16* FcT = (const h16*)(p.ws + OFF_TAB); const h16* F128 = FcT + 512 * 256;
    h16* Wtw = (h16*)p.out;
    LAS unsigned char* ldsZ = lds + 67584;
#pragma unroll
    for (int i = 0; i < 8; ++i) { const int idx = tid + 512 * i, row = idx >> 5, ch = idx & 31;
        const u32x4 v = *(const u32x4*)(U + (size_t)(t_lo + 64 * row) * 1024 + grp * 256 + ch * 8);
        *(LAS u32x4*)(lds + row * 528 + ch * 16) = v; }
    h16x8 FA3[2][8];
#pragma unroll
    for (int mi = 0; mi < 2; ++mi)
#pragma unroll
        for (int ks = 0; ks < 8; ++ks) FA3[mi][ks] = *(const h16x8*)(F128 + (16 * (2 * w + mi) + r) * 256 + 32 * ks + 8 * g);
    __syncthreads();
    for (int cb = 0; cb < 4; ++cb) {
        {
            h16x8 Bf[8];
#pragma unroll
            for (int ks = 0; ks < 8; ++ks) Bf[ks] = *(const h16x8*)(FcT + (cb * 128 + 16 * w + r) * 256 + 32 * ks + 8 * g);
            f32x4 acc[8];
#pragma unroll
            for (int mt = 0; mt < 8; ++mt) acc[mt] = (f32x4){0.f, 0.f, 0.f, 0.f};
#pragma unroll
            for (int mt = 0; mt < 8; ++mt)
#pragma unroll
                for (int ks = 0; ks < 8; ++ks) { const h16x8 a = *(const LAS h16x8*)(lds + (16 * mt + r) * 528 + (32 * ks + 8 * g) * 2);
                    acc[mt] = __builtin_amdgcn_mfma_f32_16x16x32_f16(a, Bf[ks], acc[mt], 0, 0, 0); }
            const int n_l = 16 * w + r, zrow = (n_l >> 1) * 264 + (n_l & 1) * 128;
#pragma unroll
            for (int mt = 0; mt < 8; ++mt) { u32x2 o; o.x = pkh(acc[mt][0], acc[mt][1]); o.y = pkh(acc[mt][2], acc[mt][3]);
                *(LAS u32x2*)(ldsZ + (zrow + 16 * mt + 4 * g) * 2) = o; }
        }
        __syncthreads();
        {
            f32x4 acc3[2][4];
#pragma unroll
            for (int mi = 0; mi < 2; ++mi)
#pragma unroll
                for (int nt = 0; nt < 4; ++nt) acc3[mi][nt] = (f32x4){0.f, 0.f, 0.f, 0.f};
#pragma unroll
            for (int ks = 0; ks < 8; ++ks)
#pragma unroll
                for (int nt = 0; nt < 4; ++nt) { const h16x8 b = *(const LAS h16x8*)(ldsZ + ((16 * nt + r) * 264 + 32 * ks + 8 * g) * 2);
#pragma unroll
                    for (int mi = 0; mi < 2; ++mi) acc3[mi][nt] = __builtin_amdgcn_mfma_f32_16x16x32_f16(FA3[mi][ks], b, acc3[mi][nt], 0, 0, 0); }
#pragma unroll
            for (int mi = 0; mi < 2; ++mi)
#pragma unroll
                for (int pp = 0; pp < 2; ++pp) { const int k_a = 8 * (2 * w + mi) + 2 * g + pp; const float ang = (float)(t_lo * k_a) * (1.f / 8192.f);
                    const float wr_ = __builtin_amdgcn_cosf(ang), wi_ = -__builtin_amdgcn_sinf(ang);
                    h16* dst = Wtw + ((((size_t)t_lo * 128 + k_a) * 4 + grp) * 256 + cb * 64 + r) * 2;
#pragma unroll
                    for (int nt = 0; nt < 4; ++nt) { const float re = acc3[mi][nt][2 * pp], im = acc3[mi][nt][2 * pp + 1];
                        *(unsigned*)(dst + nt * 32) = pkh(re * wr_ - im * wi_, re * wi_ + im * wr_); } }
        }
        __syncthreads();
    }
}

__device__ __forceinline__ void fb_tile(const Params& p, LAS unsigned char* lds, int tile, const h16x8 (&Bg)[4][4]) {
    const int tid = threadIdx.x, lane = tid & 63, w = __builtin_amdgcn_readfirstlane(tid >> 6), r = lane & 15, g = lane >> 4;
    const int k_a = tile & 127, grp = tile >> 7;
    const h16* Wtw = (const h16*)p.out;
    h16* mix = (h16*)(p.ws + OFF_MIX);
    LAS h16* ldsW = (LAS h16*)lds;
#pragma unroll
    for (int i = 0; i < 8; ++i) { const int mm = w * 8 + i, t_lo = 16 * (mm & 3) + (tid & 15), ch = 4 * (mm >> 2) + ((tid >> 4) & 3);
        const h16x8 v = *(const h16x8*)(Wtw + ((((size_t)t_lo * 128 + k_a) * 4 + grp) * 256 + 4 * ch) * 2);
#pragma unroll
        for (int q = 0; q < 4; ++q) { ldsW[(4 * ch + q) * 136 + t_lo] = v[2 * q]; ldsW[(4 * ch + q) * 136 + 64 + t_lo] = v[2 * q + 1]; } }
    __syncthreads();
    f32x4 acc[2][4];
#pragma unroll
    for (int mi = 0; mi < 2; ++mi)
#pragma unroll
        for (int nt = 0; nt < 4; ++nt) acc[mi][nt] = (f32x4){0.f, 0.f, 0.f, 0.f};
#pragma unroll
    for (int ks = 0; ks < 4; ++ks)
#pragma unroll
        for (int mi = 0; mi < 2; ++mi) { const h16x8 a = *(const LAS h16x8*)(ldsW + (16 * (2 * w + mi) + r) * 136 + 32 * ks + 8 * g);
#pragma unroll
            for (int nt = 0; nt < 4; ++nt) acc[mi][nt] = __builtin_amdgcn_mfma_f32_16x16x32_f16(a, Bg[nt][ks], acc[mi][nt], 0, 0, 0); }
#pragma unroll
    for (int mi = 0; mi < 2; ++mi)
#pragma unroll
        for (int nt = 0; nt < 4; ++nt) { const int tp = k_a + 128 * (16 * nt + r); u32x2 o; o.x = pkh(acc[mi][nt][0], acc[mi][nt][1]); o.y = pkh(acc[mi][nt][2], acc[mi][nt][3]);
            *(u32x2*)(mix + (size_t)tp * D + 1024 + grp * 256 + 16 * (2 * w + mi) + 4 * g) = o; }
    __syncthreads();
}

__device__ __forceinline__ void prep_item(const Params& p, LAS unsigned char* lds, int item) {
    const int tid = threadIdx.x, lane = tid & 63, w = __builtin_amdgcn_readfirstlane(tid >> 6), r = lane & 15, g = lane >> 4;
    const int n = item & 127, h = (item >> 7) & 7, d = item >> 10;
    const h16* ub = (const h16*)(p.ws + OFF_U);
    const h16* uq = ub, *uv = ub + UBLK, *uz = ub + (size_t)(2 + d) * UBLK;
    unsigned char* rec = p.ws + OFF_PQ + (size_t)item * REC_BYTES;
    h16* vfr = (h16*)((unsigned char*)p.out + 32 * MiB + (size_t)item * 16384);
    float* dec = (float*)(p.ws + OFF_DEC) + (size_t)item * 128;
    LAS unsigned short* Qb = (LAS unsigned short*)lds;
    LAS unsigned short* KIb = (LAS unsigned short*)(lds + 17408);
    LAS h16* Qh = (LAS h16*)(lds + 34816);
    LAS float* segtot = (LAS float*)(lds + 52224);
    const int k = tid & 127, seg = tid >> 7, ch = h * 128 + k;
    const float* lbl = d ? p.lbb : p.lbf;
    const float lb = __builtin_amdgcn_rcpf(1.0f + __expf(lbl[1024 + ch] - lbl[ch]));
    float bc[16], kk[16];
    float run = 0.f;
#pragma unroll
    for (int jj = 0; jj < 16; ++jj) { const int tau = 64 * n + 16 * seg + jj, t = d ? (T - 1 - tau) : tau;
        const float z = (float)uz[(size_t)t * 1024 + ch];
        const float sg = __builtin_amdgcn_rcpf(1.0f + __expf(-z));
        const float f = lb + (1.0f - lb) * sg;
        run += __logf(f); bc[jj] = run; kk[jj] = 1.0f - f; }
    segtot[seg * 128 + k] = run;
    __syncthreads();
    float pre = 0.f, tot = 0.f;
#pragma unroll
    for (int s = 0; s < 4; ++s) { const float v = segtot[s * 128 + k]; tot += v; if (s < seg) pre += v; }
    if (seg == 0) dec[k] = __expf(tot);
    {
        u32x4 ke[2]; u32x4 vv[2];
        float kef[16]; h16 vvh[16];
#pragma unroll
        for (int jj = 0; jj < 16; ++jj) { const int j = 16 * seg + jj, tau = 64 * n + j, t = d ? (T - 1 - tau) : tau;
            const float b = pre + bc[jj];
            const float q = (float)uq[(size_t)t * 1024 + ch];
            const float qd = q * __expf(b);
            Qb[j * 136 + k] = f2bf(qd); Qh[j * 136 + k] = (h16)qd;
            KIb[j * 136 + k] = f2bf(kk[jj] * __expf(-b));
            kef[jj] = kk[jj] * __expf(tot - b);
            vvh[jj] = uv[(size_t)t * 1024 + ch]; }
#pragma unroll
        for (int hh = 0; hh < 2; ++hh) { ke[hh].x = pkh(kef[8 * hh + 0], kef[8 * hh + 1]); ke[hh].y = pkh(kef[8 * hh + 2], kef[8 * hh + 3]); ke[hh].z = pkh(kef[8 * hh + 4], kef[8 * hh + 5]); ke[hh].w = pkh(kef[8 * hh + 6], kef[8 * hh + 7]);
            h16x8 t8;
#pragma unroll
            for (int e = 0; e < 8; ++e) t8[e] = vvh[8 * hh + e];
            vv[hh] = __builtin_bit_cast(u32x4, t8); }
        const int mt = k >> 4, ksp = seg >> 1;
#pragma unroll
        for (int hh = 0; hh < 2; ++hh) { const int lp = (2 * (seg & 1) + hh) * 16 + (k & 15); const size_t fo = ((size_t)(mt * 2 + ksp) * 64 + lp) * 16;
            *(u32x4*)(rec + 24576 + fo) = ke[hh];
            *(u32x4*)((unsigned char*)vfr + fo) = vv[hh]; }
    }
    __syncthreads();
#pragma unroll
    for (int i = 0; i < 4; ++i) { const int gi = tid + 512 * i, lp = gi & 63, jt = (gi >> 6) & 3, wq = gi >> 8, rr = lp & 15, gg = lp >> 4;
        const u32x2 v = *(const LAS u32x2*)(Qh + (16 * jt + rr) * 136 + 16 * wq + 4 * gg);
        *(u32x2*)(rec + 8192 + (size_t)gi * 8) = v; }
    {
        const int jt = w >> 1;
#pragma unroll
        for (int si = 0; si < 2; ++si) { const int st = 2 * (w & 1) + si;
            f32x4 a4 = (f32x4){0.f, 0.f, 0.f, 0.f};
            if (st <= jt) {
#pragma unroll
                for (int ks = 0; ks < 4; ++ks) { const s16x8 a = *(const LAS s16x8*)(KIb + (16 * st + r) * 136 + 32 * ks + 8 * g); const s16x8 b = *(const LAS s16x8*)(Qb + (16 * jt + r) * 136 + 32 * ks + 8 * g);
                    a4 = __builtin_amdgcn_mfma_f32_16x16x32_bf16(__builtin_bit_cast(__bf16 __attribute__((ext_vector_type(8))), a), __builtin_bit_cast(__bf16 __attribute__((ext_vector_type(8))), b), a4, 0, 0, 0); }
            }
            const int j = 16 * jt + r;
#pragma unroll
            for (int i = 0; i < 4; ++i) { const int s = 16 * st + 4 * g + i; if (s > j) a4[i] = 0.f; }
            u32x2 o; o.x = pkh(a4[0], a4[1]); o.y = pkh(a4[2], a4[3]);
            const int lp = (2 * (st & 1) + (g >> 1)) * 16 + r;
            *(u32x2*)(rec + ((size_t)(jt * 2 + (st >> 1)) * 64 + lp) * 16 + 8 * (g & 1)) = o; }
    }
    __syncthreads();
}

struct StepLd { h16x8 ke0, ke1, bv0, bv1, pf; h16x4 q[4]; f32x4 dec; };
__device__ __forceinline__ void scan_load(StepLd& L, const unsigned char* rec0, const unsigned char* vf0, const float* dec0, int n, int w, int lane, int vs) {
    n = n < 127 ? n : 127;
    const unsigned char* rec = rec0 + (size_t)n * REC_BYTES;
    L.pf = *(const h16x8*)(rec + ((size_t)((w & 3) * 2 + (w >> 2)) * 64 + lane) * 16);
#pragma unroll
    for (int jt = 0; jt < 4; ++jt) L.q[jt] = *(const h16x4*)(rec + 8192 + ((size_t)(w * 4 + jt) * 64 + lane) * 8);
    L.ke0 = *(const h16x8*)(rec + 24576 + ((size_t)(w * 2 + 0) * 64 + lane) * 16);
    L.ke1 = *(const h16x8*)(rec + 24576 + ((size_t)(w * 2 + 1) * 64 + lane) * 16);
    const unsigned char* vf = vf0 + (size_t)n * 16384;
    L.bv0 = *(const h16x8*)(vf + ((size_t)(vs * 2 + 0) * 64 + lane) * 16);
    L.bv1 = *(const h16x8*)(vf + ((size_t)(vs * 2 + 1) * 64 + lane) * 16);
    L.dec = *(const f32x4*)(dec0 + (size_t)n * 128 + 16 * w + 4 * (lane >> 4));
}
__device__ __forceinline__ void scan_step(const StepLd& L, f32x4& S, LAS unsigned char* lds, float* od, int n, int d, int w, int lane) {
    const h16x4 sb = __builtin_convertvector(S, h16x4);
    f32x4 o[4];
#pragma unroll
    for (int jt = 0; jt < 4; ++jt) o[jt] = __builtin_amdgcn_mfma_f32_16x16x16f16(L.q[jt], sb, (f32x4){0.f, 0.f, 0.f, 0.f}, 0, 0, 0);
    const h16x8 bvp = (w >> 2) ? L.bv1 : L.bv0;
#pragma unroll
    for (int jt = 0; jt < 4; ++jt) if (jt == (w & 3)) o[jt] = __builtin_amdgcn_mfma_f32_16x16x32_f16(L.pf, bvp, o[jt], 0, 0, 0);
    S = S * L.dec;
    S = __builtin_amdgcn_mfma_f32_16x16x32_f16(L.ke0, L.bv0, S, 0, 0, 0);
    S = __builtin_amdgcn_mfma_f32_16x16x32_f16(L.ke1, L.bv1, S, 0, 0, 0);
    LAS unsigned char* pb = lds + (n & 1) * 32768;
#pragma unroll
    for (int jt = 0; jt < 4; ++jt) *(LAS f32x4*)(pb + ((w * 4 + jt) * 64 + lane) * 16) = o[jt];
    asm volatile("s_waitcnt lgkmcnt(0)" ::: "memory"); __builtin_amdgcn_s_barrier(); asm volatile("" ::: "memory");
    if (w < 4) {
        f32x4 tot = (f32x4){0.f, 0.f, 0.f, 0.f};
#pragma unroll
        for (int ww = 0; ww < 8; ++ww) tot += *(const LAS f32x4*)(pb + ((ww * 4 + w) * 64 + lane) * 16);
        const int r = lane & 15, g = lane >> 4;
#pragma unroll
        for (int i = 0; i < 4; ++i) { const int tau = 64 * n + 16 * w + 4 * g + i, t = d ? (T - 1 - tau) : tau; od[(size_t)t * 1024 + r] = tot[i]; }
    }
}
__device__ __forceinline__ void scan_job(const Params& p, LAS unsigned char* lds, int job) {
    const int tid = threadIdx.x, lane = tid & 63, w = __builtin_amdgcn_readfirstlane(tid >> 6);
    const int hd = (job & 7) * 2 + (job >> 6), vs = (job >> 3) & 7, h = hd & 7, d = hd >> 3;
    const size_t item0 = (size_t)(d * 8 + h) * 128;
    const unsigned char* rec0 = p.ws + OFF_PQ + item0 * REC_BYTES;
    const unsigned char* vf0 = (const unsigned char*)p.out + 32 * MiB + item0 * 16384;
    const float* dec0 = (const float*)(p.ws + OFF_DEC) + item0 * 128;
    float* od = (float*)(p.ws + OFF_ODIR) + (size_t)d * T * 1024 + h * 128 + vs * 16;
    f32x4 S = (f32x4){0.f, 0.f, 0.f, 0.f};
    StepLd b0, b1, b2, b3;
    scan_load(b0, rec0, vf0, dec0, 0, w, lane, vs); scan_load(b1, rec0, vf0, dec0, 1, w, lane, vs); scan_load(b2, rec0, vf0, dec0, 2, w, lane, vs);
    for (int n = 0; n < 128; n += 4) {
        scan_load(b3, rec0, vf0, dec0, n + 3, w, lane, vs); scan_step(b0, S, lds, od, n, d, w, lane);
        scan_load(b0, rec0, vf0, dec0, n + 4, w, lane, vs); scan_step(b1, S, lds, od, n + 1, d, w, lane);
        scan_load(b1, rec0, vf0, dec0, n + 5, w, lane, vs); scan_step(b2, S, lds, od, n + 2, d, w, lane);
        scan_load(b2, rec0, vf0, dec0, n + 6, w, lane, vs); scan_step(b3, S, lds, od, n + 3, d, w, lane);
    }
    __syncthreads();
}

__device__ __forceinline__ void phase4(const Params& p, LAS unsigned char* lds) {
    const int tid = threadIdx.x, lane = tid & 63, wave = tid >> 6, G = gridDim.x;
    const int gw = blockIdx.x * 8 + wave, NGW = G * 8;
    const float* of = (const float*)(p.ws + OFF_ODIR); const float* ob = of + (size_t)T * 1024;
    const h16* ug = (const h16*)(p.ws + OFF_U) + 5 * UBLK;
    h16* mix = (h16*)(p.ws + OFF_MIX);
    const f32x2 gn = *((const f32x2*)p.g_norm + lane);
    for (int t = gw; t < T; t += NGW) {
        f32x2 a[8], b[8]; h16x2 gv[8];
#pragma unroll
        for (int h = 0; h < 8; ++h) { const size_t o = (size_t)t * 1024 + h * 128 + 2 * lane; a[h] = *(const f32x2*)(of + o); b[h] = *(const f32x2*)(ob + o); gv[h] = *(const h16x2*)(ug + o); }
#pragma unroll
        for (int h = 0; h < 8; ++h) { const float o0 = a[h].x + b[h].x, o1 = a[h].y + b[h].y;
            const float ss = wave_sum(o0 * o0 + o1 * o1); const float rs = __builtin_amdgcn_rsqf(ss * (1.f / 128.f) + RMS_EPS);
            *(unsigned*)(mix + (size_t)t * D + h * 128 + 2 * lane) = pkh(o0 * rs * gn.x * (float)gv[h].x, o1 * rs * gn.y * (float)gv[h].y); }
    }
    LAS float* scr = (LAS float*)(lds + wave * 8448);
    constexpr int I_G = (D / 64) * (FF / 32), I_D = (FF / 64) * (D / 32);
    for (int it = gw; it < 2 * I_G + I_D; it += NGW) {
        if (it < I_G) transpose_item(p.w_gate, D, FF, (h16*)(p.ws + OFF_WGU), scr, it, lane, RmGate());
        else if (it < 2 * I_G) transpose_item(p.w_up, D, FF, (h16*)(p.ws + OFF_WGU), scr, it - I_G, lane, RmUp());
        else transpose_item(p.w_down, FF, D, (h16*)(p.ws + OFF_WD), scr, it - 2 * I_G, lane, RmId());
    }
}

__global__ void __launch_bounds__(512, 2) fwd_megakernel(Params p) {
    extern __shared__ __attribute__((aligned(16))) unsigned char shm[];
    LAS unsigned char* lds = (LAS unsigned char*)shm;
    const int G = gridDim.x, bid = blockIdx.x, tid = threadIdx.x, lane = tid & 63, wave = tid >> 6;
    const int gw = bid * 8 + wave, NGW = G * 8;
#ifndef PROBE_MASK
#define PROBE_MASK 0
#endif
#define RUN(ph) if (p.ph_lo <= (ph) && (ph) < p.ph_hi)
#define SYNC(ph) do { if (p.ph_lo < (ph) && (ph) < p.ph_hi) cg::this_grid().sync(); } while (0)
    RUN(0) phase0(p, lds);
    SYNC(1);
    RUN(1) { pg8::Gemm g{(const h16*)(p.ws + OFF_H0), (const h16*)(p.ws + OFF_WIN), T, PW, D}; pg8::StaticOrder S; S.init(T, PW, G, bid);
        pg8::EpiU E{(h16*)(p.ws + OFF_U)}; pg8::gemm_phase(lds, g, S, E); }
    SYNC(2);
    RUN(2) {
        for (int tile = bid; tile < 256; tile += G) fa_tile(p, lds, tile);
        for (int item = bid; item < 2048; item += G) prep_item(p, lds, item);
    }
    SYNC(3);
    RUN(3) {
        for (int job = bid; job < 128; job += G) scan_job(p, lds, job);
        const int fb0 = G > 128 ? 128 : 0, nfb = G - fb0;
        if (bid >= fb0) {
            const int r = lane & 15, g = lane >> 4;
            const h16* G64 = (const h16*)(p.ws + OFF_TAB) + 512 * 256 + 256 * 256;
            h16x8 Bg[4][4];
#pragma unroll
            for (int nt = 0; nt < 4; ++nt)
#pragma unroll
                for (int ks = 0; ks < 4; ++ks) Bg[nt][ks] = *(const h16x8*)(G64 + (16 * nt + r) * 128 + 32 * ks + 8 * g);
            for (int tile = bid - fb0; tile < 512; tile += nfb) fb_tile(p, lds, tile, Bg);
        }
    }
    SYNC(4);
    RUN(4) phase4(p, lds);
    SYNC(5);
    RUN(5) { pg8::Gemm g{(const h16*)(p.ws + OFF_MIX), (const h16*)(p.ws + OFF_WOUT), T, D, D}; pg8::StaticOrder S; S.init(T, D, G, bid);
        pg8::EpiRes E{p.out, (const h16*)(p.ws + OFF_H0)}; pg8::gemm_phase(lds, g, S, E); }
    SYNC(6);
    RUN(6) { h16* h1 = (h16*)(p.ws + OFF_H0);
        LnAff A; ln_load_aff(A, p.ln1_g, p.ln1_b, lane);
        for (int r = gw; r < T; r += NGW) ln_row<false>(p.out + (size_t)r * D, A, h1 + (size_t)r * D, lane); }
    SYNC(7);
    RUN(7) { pg8::Gemm g{(const h16*)(p.ws + OFF_H0), (const h16*)(p.ws + OFF_WGU), T, 2 * FF, D}; pg8::StaticOrder S; S.init(T, 2 * FF, G, bid);
        pg8::EpiGlu E{(h16*)(p.ws + OFF_ACT)}; pg8::gemm_phase(lds, g, S, E); }
    SYNC(8);
    RUN(8) { pg8::Gemm g{(const h16*)(p.ws + OFF_ACT), (const h16*)(p.ws + OFF_WD), T, D, FF}; pg8::StaticOrder S; S.init(T, D, G, bid);
        pg8::EpiRes E{p.out, (const h16*)(p.ws + OFF_H0)}; pg8::gemm_phase(lds, g, S, E); }
    SYNC(9);
    RUN(9) { LnAff A; ln_load_aff(A, p.ln2_g, p.ln2_b, lane);
        for (int r = gw; r < T; r += NGW) ln_row<true>(p.out + (size_t)r * D, A, p.out + (size_t)r * D, lane); }
}

extern "C" void kernel_launch(void* const* d_in, const int* in_sizes, int n_in, void* d_out, int out_size, void* d_ws, size_t ws_size, hipStream_t stream) {
    static int grid = 0;
    if (grid == 0) {
        if (n_in != 15 || in_sizes[0] != T * D || out_size != T * D || ws_size < WS_NEED) { fprintf(stderr, "kernel_launch: unexpected shapes (n_in %d in0 %d out %d ws %zu)\n", n_in, n_in > 0 ? in_sizes[0] : -1, out_size, ws_size); grid = -1; return; }
        int dev = 0, cus = 0, per_cu = 0;
        hipGetDevice(&dev); hipDeviceGetAttribute(&cus, hipDeviceAttributeMultiprocessorCount, dev);
        if (hipFuncSetAttribute((const void*)fwd_megakernel, hipFuncAttributeMaxDynamicSharedMemorySize, LDS_BYTES) != hipSuccess) { fprintf(stderr, "kernel_launch: hipFuncSetAttribute failed\n"); grid = -1; return; }
        if (hipOccupancyMaxActiveBlocksPerMultiprocessor(&per_cu, (const void*)fwd_megakernel, 512, LDS_BYTES) != hipSuccess || per_cu < 1) { fprintf(stderr, "kernel_launch: occupancy query gave %d\n", per_cu); per_cu = 1; }
        (void)hipGetLastError();
        grid = cus * 1;
        if (grid > 256) grid = 256;
    }
    if (grid < 0) return;
    Params p{};
    p.x = (const float*)d_in[0]; p.ln_emb_g = (const float*)d_in[1]; p.ln_emb_b = (const float*)d_in[2]; p.w_in = (const float*)d_in[3];
    p.lbf = (const float*)d_in[4]; p.lbb = (const float*)d_in[5]; p.g_norm = (const float*)d_in[6]; p.w_out = (const float*)d_in[7];
    p.ln1_g = (const float*)d_in[8]; p.ln1_b = (const float*)d_in[9]; p.w_gate = (const float*)d_in[10]; p.w_up = (const float*)d_in[11];
    p.w_down = (const float*)d_in[12]; p.ln2_g = (const float*)d_in[13]; p.ln2_b = (const float*)d_in[14];
    p.out = (float*)d_out; p.ws = (unsigned char*)d_ws;
#if N_LAUNCH_MODE == 1
    p.ph_lo = 0; p.ph_hi = 10;
    void* args[] = {&p};
    hipError_t e = hipLaunchCooperativeKernel((const void*)fwd_megakernel, dim3(grid), dim3(512), args, LDS_BYTES, stream);
    if (e != hipSuccess) fprintf(stderr, "cooperative launch failed: %s (grid %d)\n", hipGetErrorString(e), grid);
#else
    for (int ph = 0; ph < 10; ++ph) for (int rp = 0; rp < 1 + ((PROBE_MASK >> ph) & 1); ++rp) { p.ph_lo = ph; p.ph_hi = ph + 1; hipLaunchKernelGGL(fwd_megakernel, dim3(grid), dim3(512), LDS_BYTES, stream, p); }
#endif
}
```

```cpp
#include <hip/hip_runtime.h>
#include <hip/hip_cooperative_groups.h>
#include <cstdio>
#include <cstdint>
namespace cg = cooperative_groups;

#ifndef TS_SEL
#define TS_SEL 0
#endif
#ifndef N_LAUNCH_MODE
#define N_LAUNCH_MODE 1
#endif

#define LAS __attribute__((address_space(3)))
typedef _Float16 h16;
typedef _Float16 h16x8 __attribute__((ext_vector_type(8)));
typedef _Float16 h16x4 __attribute__((ext_vector_type(4)));
typedef _Float16 h16x2 __attribute__((ext_vector_type(2)));
typedef short s16x8 __attribute__((ext_vector_type(8)));
typedef float f32x4 __attribute__((ext_vector_type(4)));
typedef float f32x2 __attribute__((ext_vector_type(2)));
typedef unsigned u32x4 __attribute__((ext_vector_type(4)));
typedef unsigned u32x2 __attribute__((ext_vector_type(2)));

constexpr int T = 8192, D = 2048, PW = 6144, FF = 5632, HW = 1024;
constexpr float ALPHA = 1.189207115002721f;
constexpr float LN_EPS = 1e-5f, RMS_EPS = 1e-6f;
constexpr size_t MiB = 1ull << 20;
constexpr size_t OFF_H0 = 0;
constexpr size_t OFF_WOUT = 32 * MiB;
constexpr size_t OFF_WIN = 40 * MiB;
constexpr size_t OFF_U = 64 * MiB;
constexpr size_t OFF_PQ = 160 * MiB;
constexpr size_t OFF_DEC = 240 * MiB;
constexpr size_t OFF_TAB = 241 * MiB;
constexpr size_t OFF_ODIR = 40 * MiB;
constexpr size_t OFF_MIX = 104 * MiB;
constexpr size_t OFF_WD = 204 * MiB;
constexpr size_t OFF_ACT = 40 * MiB;
constexpr size_t OFF_CUMB = 242 * MiB;
constexpr size_t OFF_SFIN = 243 * MiB;
constexpr size_t OFF_XB5 = 243 * MiB + 512 * 1024;
constexpr size_t OFF_XB8 = 240 * MiB;
constexpr size_t OFF_CNT = 241 * MiB + 900 * 1024;
constexpr size_t OFF_BAR = 241 * MiB + 920 * 1024;
constexpr size_t WS_NEED = 244 * MiB;
constexpr size_t UBLK = (size_t)T * 1024;
constexpr int REC_BYTES = 40960;
constexpr int LDS_BYTES = 131072 + 16;

struct Params {
    const float *x, *ln_emb_g, *ln_emb_b, *w_in, *lbf, *lbb, *g_norm, *w_out, *ln1_g, *ln1_b, *w_gate, *w_up, *w_down, *ln2_g, *ln2_b;
    float* out; unsigned char* ws; int ph_lo, ph_hi;
};

__device__ __forceinline__ float wave_sum(float v) {
#pragma unroll
    for (int o = 1; o < 64; o <<= 1) v += __shfl_xor(v, o);
    return v;
}
__device__ __forceinline__ float silu_f(float x) { return x * __builtin_amdgcn_rcpf(1.0f + __expf(-x)); }
__device__ __forceinline__ unsigned short f2bf(float f) { unsigned u = __float_as_uint(f); u += 0x7FFFu + ((u >> 16) & 1u); return (unsigned short)(u >> 16); }
__device__ __forceinline__ unsigned pkh(float a, float b) { h16x2 v; v.x = (h16)a; v.y = (h16)b; return __builtin_bit_cast(unsigned, v); }
#ifndef GEMM_BF16
#define GEMM_BF16 1
#endif
typedef __bf16 bf16x8_t __attribute__((ext_vector_type(8)));
__device__ __forceinline__ unsigned pko(float a, float b) {
#if GEMM_BF16
    typedef __bf16 bf16x2_t __attribute__((ext_vector_type(2))); bf16x2_t v; v.x = (__bf16)a; v.y = (__bf16)b; return __builtin_bit_cast(unsigned, v);
#else
    return pkh(a, b);
#endif
}
__device__ __forceinline__ float opf(h16 raw) {
#if GEMM_BF16
    return __uint_as_float((unsigned)__builtin_bit_cast(unsigned short, raw) << 16);
#else
    return (float)raw;
#endif
}
#define LDS_WAIT() asm volatile("s_waitcnt lgkmcnt(0)" ::: "memory")
#define LBAR() do { asm volatile("s_waitcnt lgkmcnt(0)" ::: "memory"); __builtin_amdgcn_s_barrier(); asm volatile("" ::: "memory"); } while (0)

namespace pg8 {
constexpr int BM = 256, BK = 64, HALF = 128, HTB = HALF * BK * 2, STAGE_BYTES = 8 * HTB, NXCD = 8, WGM = 8;
__device__ __forceinline__ int lds_byte(int r, int c) { const int st = (r >> 4) * 2 + (c >> 5), rr = r & 15, cc = c & 31, ob = rr * 64 + cc * 2; return st * 1024 + (ob ^ (((ob >> 9) & 1) << 5)); }
__device__ __forceinline__ void stage_rc(int b, int& R, int& C) { const int st = b / 1024, sb = b % 1024, swz = sb ^ (((sb >> 9) & 1) << 5); R = (st >> 1) * 16 + swz / 64; C = (st & 1) * 32 + (swz % 64) / 2; }
__device__ __forceinline__ int perm32(int rho) { const int n = rho >> 4, i = rho & 15; return 8 * (i >> 2) + 4 * n + (i & 3); }
struct Unit { int pm, pn; };
struct Gemm { const h16* A; const h16* Bt; int M, N, K; };
struct StaticOrder {
    int nM, nN, nwg, G, c;
    __device__ void init(int M, int N, int G_, int c_) { nM = M / BM; nN = N / BM; nwg = nM * nN; G = G_; c = c_; }
    unsigned* ctr;
    __device__ bool next(int i, Unit& u) const { return map((long)i * G + c, u); }
    __device__ bool map(long L, Unit& u) const {
        if (L >= nwg) return false;
        int wgid = (int)L; { const int q = nwg / NXCD, r = nwg % NXCD, xcd = wgid % NXCD, off = wgid / NXCD; wgid = (xcd < r ? xcd * (q + 1) : r * (q + 1) + (xcd - r) * q) + off; }
        const int nig = WGM * nN, gid = wgid / nig, fm = gid * WGM, gsz = (nM - fm) < WGM ? (nM - fm) : WGM;
        u.pm = fm + ((wgid % nig) % gsz); u.pn = (wgid % nig) / gsz; return true;
    }
};

template <class Epi, bool DYN = false>
__device__ __forceinline__ void gemm_phase(LAS unsigned char* lds, const Gemm g, const StaticOrder& S, const Epi& E) {
    const int tid = threadIdx.x, wid = __builtin_amdgcn_readfirstlane(tid >> 6), lane = tid & 63, wr = wid >> 2, wc = wid & 3, fr = lane & 15, fq = lane >> 4;
    const int K = g.K, nt = K / BK;
    unsigned voffA[2], voffB[2];
#pragma unroll
    for (int i = 0; i < 2; ++i) { int R, C; stage_rc(tid * 16 + i * 8192, R, C); const int Rb = Epi::PERM ? ((R & ~31) + perm32(R & 31)) : R;
        voffA[i] = (unsigned)(R * K + C) * 2u; voffB[i] = (unsigned)(Rb * K + C) * 2u; }
    const size_t kstep = (size_t)(BK * 2);
    const size_t hstep = (size_t)HALF * K * 2;
    const size_t tstep = 2 * hstep;
    const unsigned ldsw = (unsigned)wid * 1024u;
    const int aoff = lds_byte(wr * 64 + fr, fq * 8), boff = lds_byte(wc * 32 + fr, fq * 8);
#define PG8_SA(b, h) (((b) * 2 + (h)) * HTB)
#define PG8_SB(b, h) ((4 + (b) * 2 + (h)) * HTB)
#define PG8_STAGE(bufoff, gbase, voff) do { _Pragma("unroll") for (int _i = 0; _i < 2; ++_i) \
        __builtin_amdgcn_global_load_lds((const unsigned*)((const char*)(gbase) + (voff)[_i]), (LAS unsigned*)(lds + (bufoff) + ldsw + _i * 8192), 16, 0, 0); } while (0)
#define PG8_LDA(dst, b, h) do { _Pragma("unroll") for (int m = 0; m < 4; ++m) _Pragma("unroll") for (int k = 0; k < 2; ++k) dst[m][k] = *(const LAS h16x8*)(lds + PG8_SA(b, h) + aoff + m * 2048 + k * 1024); } while (0)
#define PG8_LDB(dst, b, h) do { _Pragma("unroll") for (int n = 0; n < 2; ++n) _Pragma("unroll") for (int k = 0; k < 2; ++k) dst[n][k] = *(const LAS h16x8*)(lds + PG8_SB(b, h) + boff + n * 2048 + k * 1024); } while (0)
#define PG8_MMA(ai, bj, At, Bt) do { __builtin_amdgcn_s_setprio(1); _Pragma("unroll") for (int m = 0; m < 4; ++m) _Pragma("unroll") for (int n = 0; n < 2; ++n) _Pragma("unroll") for (int k = 0; k < 2; ++k) \
        acc[ai][bj][m][n] = GEMM_BF16 ? __builtin_amdgcn_mfma_f32_16x16x32_bf16(__builtin_bit_cast(bf16x8_t, Bt[n][k]), __builtin_bit_cast(bf16x8_t, At[m][k]), acc[ai][bj][m][n], 0, 0, 0) : __builtin_amdgcn_mfma_f32_16x16x32_f16(Bt[n][k], At[m][k], acc[ai][bj][m][n], 0, 0, 0); __builtin_amdgcn_s_setprio(0); } while (0)
#define PG8_WAIT_V(n) asm volatile("s_waitcnt vmcnt(" #n ")" ::: "memory")
#define PG8_WAIT_L(n) asm volatile("s_waitcnt lgkmcnt(" #n ")" ::: "memory")
#define PG8_BAR __builtin_amdgcn_s_barrier()
#define PG8_SCHED __builtin_amdgcn_sched_barrier(0)
    Unit cur, nxt; int ui = 0;
    long Lnext = (long)S.G + S.c;
    if (!S.next(0, cur)) return;
    f32x4 acc[2][2][4][2];
#pragma unroll
    for (int a = 0; a < 2; ++a)
#pragma unroll
        for (int b = 0; b < 2; ++b)
#pragma unroll
            for (int m = 0; m < 4; ++m)
#pragma unroll
                for (int n = 0; n < 2; ++n) acc[a][b][m][n] = (f32x4){0.f, 0.f, 0.f, 0.f};
    h16x8 At[4][2], B0[2][2], B1[2][2];
    const char* cA = (const char*)g.A + (size_t)cur.pm * tstep; const char* cB = (const char*)g.Bt + (size_t)cur.pn * tstep;
    PG8_STAGE(PG8_SB(0, 0), cB, voffB); PG8_STAGE(PG8_SB(0, 1), cB + hstep, voffB); PG8_STAGE(PG8_SA(0, 0), cA, voffA); PG8_STAGE(PG8_SA(0, 1), cA + hstep, voffA);
    if (wr == 1) PG8_BAR;
    PG8_WAIT_V(2); PG8_BAR;
    PG8_STAGE(PG8_SB(1, 0), cB + kstep, voffB); PG8_STAGE(PG8_SA(1, 0), cA + kstep, voffA); PG8_STAGE(PG8_SB(1, 1), cB + hstep + kstep, voffB);
    PG8_WAIT_V(6); PG8_BAR;
    for (;;) {
        const bool has_next = DYN ? S.map(Lnext, nxt) : S.next(ui + 1, nxt);
        const char* nA = has_next ? (const char*)g.A + (size_t)nxt.pm * tstep : cA; const char* nB = has_next ? (const char*)g.Bt + (size_t)nxt.pn * tstep : cB;
        for (int t = 0; t < nt; t += 2) {
            const bool last = (t == nt - 2);
            const char* a1 = cA + (size_t)(t + 1) * kstep;
            const char* a2 = last ? nA : cA + (size_t)(t + 2) * kstep; const char* b2 = last ? nB : cB + (size_t)(t + 2) * kstep;
            const char* a3 = a2 + kstep; const char* b3 = b2 + kstep;
            PG8_LDB(B0, 0, 0); PG8_LDB(B1, 0, 1); PG8_SCHED; PG8_LDA(At, 0, 0); PG8_STAGE(PG8_SA(1, 1), a1 + hstep, voffA);
            PG8_WAIT_V(8); PG8_WAIT_L(0); PG8_BAR; PG8_MMA(0, 0, At, B0); PG8_MMA(0, 1, At, B1); PG8_BAR; PG8_SCHED;
            PG8_LDA(At, 0, 1); PG8_STAGE(PG8_SB(0, 0), b2, voffB); PG8_STAGE(PG8_SB(0, 1), b2 + hstep, voffB); PG8_STAGE(PG8_SA(0, 0), a2, voffA);
            PG8_WAIT_V(8); PG8_WAIT_L(0); PG8_BAR; PG8_MMA(1, 0, At, B0); PG8_MMA(1, 1, At, B1); PG8_BAR; PG8_SCHED;
            PG8_LDB(B0, 1, 0); PG8_LDB(B1, 1, 1); PG8_SCHED; PG8_LDA(At, 1, 0); PG8_STAGE(PG8_SA(0, 1), a2 + hstep, voffA);
            PG8_WAIT_V(8); PG8_WAIT_L(0); PG8_BAR; PG8_MMA(0, 0, At, B0); PG8_MMA(0, 1, At, B1); PG8_BAR; PG8_SCHED;
            PG8_LDA(At, 1, 1); PG8_STAGE(PG8_SB(1, 0), b3, voffB); PG8_STAGE(PG8_SB(1, 1), b3 + hstep, voffB); PG8_STAGE(PG8_SA(1, 0), a3, voffA);
            PG8_WAIT_V(8); PG8_WAIT_L(0); PG8_BAR; PG8_MMA(1, 0, At, B0); PG8_MMA(1, 1, At, B1); PG8_BAR; PG8_SCHED;
        }
        if (wr == 0) PG8_BAR;
        unsigned claimed = 0u;
        if constexpr (DYN) { if (has_next && tid == 0) claimed = 2u * (unsigned)S.G + __hip_atomic_fetch_add(S.ctr, 1u, __ATOMIC_RELAXED, __HIP_MEMORY_SCOPE_AGENT); }
        if constexpr (!Epi::AFTER_DRAIN) E(acc, cur, wr, wc, fr, fq);
        if (!has_next) break;
        if constexpr (DYN) {
            LAS unsigned* slot = (LAS unsigned*)(lds + 131072 + 8);
            if (tid == 0) *slot = claimed;
            asm volatile("s_waitcnt lgkmcnt(0)" ::: "memory"); PG8_BAR; asm volatile("" ::: "memory");
            Lnext = (long)*slot;
        }
#pragma unroll
        for (int a = 0; a < 2; ++a)
#pragma unroll
            for (int b = 0; b < 2; ++b)
#pragma unroll
                for (int m = 0; m < 4; ++m)
#pragma unroll
                    for (int n = 0; n < 2; ++n) acc[a][b][m][n] = (f32x4){0.f, 0.f, 0.f, 0.f};
        cur = nxt; cA = nA; cB = nB; ++ui;
        if (wr == 1) PG8_BAR;
    }
    PG8_WAIT_V(0);
    PG8_BAR;
    if constexpr (Epi::AFTER_DRAIN) E.fused(acc, cur, wr, wc, fr, fq, lds, wid, lane);
#undef PG8_SA
#undef PG8_SB
#undef PG8_STAGE
#undef PG8_LDA
#undef PG8_LDB
#undef PG8_MMA
#undef PG8_WAIT_V
#undef PG8_WAIT_L
#undef PG8_BAR
#undef PG8_SCHED
}

struct EpiU {
    static constexpr bool PERM = true, AFTER_DRAIN = false;
    h16* ubase;
    __device__ __forceinline__ void operator()(const f32x4 (&acc)[2][2][4][2], const Unit& u, int wr, int wc, int fr, int fq) const {
        const int row0 = u.pm * BM + wr * 64 + fr; int colt = u.pn * BM; const int blk = colt >> 10; colt &= 1023;
        const int dblk = blk == 4 ? 5 : (blk == 5 ? 4 : blk);
        h16* base = ubase + (size_t)dblk * UBLK; const bool act = (blk == 0) || (blk == 4);
        const int col0 = colt + wc * 32 + 8 * fq;
#pragma unroll
        for (int ai = 0; ai < 2; ++ai)
#pragma unroll
            for (int m = 0; m < 4; ++m) { h16* rowp = base + (size_t)(row0 + ai * HALF + m * 16) * 1024 + col0;
#pragma unroll
                for (int bj = 0; bj < 2; ++bj) { f32x4 v0 = acc[ai][bj][m][0], v1 = acc[ai][bj][m][1];
                    if (act) {
#pragma unroll
                        for (int j = 0; j < 4; ++j) { v0[j] = silu_f(v0[j]); v1[j] = silu_f(v1[j]); } }
                    u32x4 w; w.x = pkh(v0[0], v0[1]); w.y = pkh(v0[2], v0[3]); w.z = pkh(v1[0], v1[1]); w.w = pkh(v1[2], v1[3]);
                    *(u32x4*)(rowp + bj * HALF) = w; } }
    }
};
template <bool FINAL> struct EpiLn {
    static constexpr bool PERM = false, AFTER_DRAIN = true;
    const h16* H; void* O; const float* gam; const float* bet; float* xbuf; unsigned* cnt;
    __device__ __forceinline__ void operator()(const f32x4 (&)[2][2][4][2], const Unit&, int, int, int, int) const {}
    __device__ __forceinline__ void fused(const f32x4 (&acc)[2][2][4][2], const Unit& u, int wr, int wc, int fr, int fq, LAS unsigned char* lds, int wid, int lane) const {
        const int row0 = u.pm * BM + wr * 64 + fr, col0 = u.pn * BM + wc * 32 + 4 * fq, tid = wid * 64 + lane;
        f32x4 y[2][2][4][2];
#pragma unroll
        for (int ai = 0; ai < 2; ++ai) {
            h16x4 hv[4][2][2];
#pragma unroll
            for (int m = 0; m < 4; ++m)
#pragma unroll
                for (int bj = 0; bj < 2; ++bj)
#pragma unroll
                    for (int n = 0; n < 2; ++n) hv[m][bj][n] = *(const h16x4*)(H + (size_t)(row0 + ai * HALF + m * 16) * D + col0 + bj * HALF + n * 16);
#pragma unroll
            for (int m = 0; m < 4; ++m)
#pragma unroll
                for (int bj = 0; bj < 2; ++bj)
#pragma unroll
                    for (int n = 0; n < 2; ++n) { f32x4 v = acc[ai][bj][m][n]; const h16x4 h4 = hv[m][bj][n];
                        v[0] += ALPHA * opf(h4[0]); v[1] += ALPHA * opf(h4[1]); v[2] += ALPHA * opf(h4[2]); v[3] += ALPHA * opf(h4[3]); y[ai][bj][m][n] = v; }
        }
        LAS f32x2* P = (LAS f32x2*)lds;
        LAS f32x2* Sm = (LAS f32x2*)(lds + 8192);
#pragma unroll
        for (int ai = 0; ai < 2; ++ai)
#pragma unroll
            for (int m = 0; m < 4; ++m) { float s1 = 0.f, s2 = 0.f;
#pragma unroll
                for (int bj = 0; bj < 2; ++bj)
#pragma unroll
                    for (int n = 0; n < 2; ++n) { const f32x4 v = y[ai][bj][m][n]; s1 += (v[0] + v[1]) + (v[2] + v[3]); s2 += (v[0] * v[0] + v[1] * v[1]) + (v[2] * v[2] + v[3] * v[3]); }
                s1 += __shfl_xor(s1, 16); s1 += __shfl_xor(s1, 32); s2 += __shfl_xor(s2, 16); s2 += __shfl_xor(s2, 32);
                if (fq == 0) P[(ai * HALF + wr * 64 + m * 16 + fr) * 4 + wc] = (f32x2){s1, s2}; }
        __syncthreads();
        if (tid < 256) { const f32x2 a = P[tid * 4 + 0], b = P[tid * 4 + 1], c = P[tid * 4 + 2], d = P[tid * 4 + 3];
            float* xp = xbuf + ((size_t)(u.pm * 256 + tid) * 8 + u.pn) * 2;
            __hip_atomic_store(xp, (a.x + b.x) + (c.x + d.x), __ATOMIC_RELAXED, __HIP_MEMORY_SCOPE_AGENT);
            __hip_atomic_store(xp + 1, (a.y + b.y) + (c.y + d.y), __ATOMIC_RELAXED, __HIP_MEMORY_SCOPE_AGENT); }
        asm volatile("s_waitcnt vmcnt(0)" ::: "memory");
        __syncthreads();
        if (tid == 0) {
            unsigned* c = cnt + 64 * u.pm;
            __hip_atomic_fetch_add(c, 1u, __ATOMIC_RELAXED, __HIP_MEMORY_SCOPE_AGENT);
            unsigned spins = 0;
            while (__hip_atomic_load(c, __ATOMIC_RELAXED, __HIP_MEMORY_SCOPE_AGENT) < 8u && ++spins < (1u << 24)) __builtin_amdgcn_s_sleep(2);
        }
        __syncthreads();
        if (tid < 256) { float s1 = 0.f, s2 = 0.f; const float* xp = xbuf + (size_t)(u.pm * 256 + tid) * 16;
#pragma unroll
            for (int k = 0; k < 8; ++k) { s1 += __hip_atomic_load(xp + 2 * k, __ATOMIC_RELAXED, __HIP_MEMORY_SCOPE_AGENT); s2 += __hip_atomic_load(xp + 2 * k + 1, __ATOMIC_RELAXED, __HIP_MEMORY_SCOPE_AGENT); }
            const float mean = s1 * (1.f / D), var = s2 * (1.f / D) - mean * mean;
            Sm[tid] = (f32x2){mean, __builtin_amdgcn_rsqf(var + LN_EPS)}; }
        __syncthreads();
        f32x4 gg[2][2], bb[2][2];
        float dl = 0.f;
        if (FINAL && TS_SEL) { const unsigned long long* ts = (const unsigned long long*)((const unsigned char*)cnt - 2048 * 4 - 900 * 1024 + 600 * 1024); dl = (float)(ts[TS_SEL] - ts[0]) * 1e-6f; }
#pragma unroll
        for (int bj = 0; bj < 2; ++bj)
#pragma unroll
            for (int n = 0; n < 2; ++n) { gg[bj][n] = *(const f32x4*)(gam + col0 + bj * HALF + n * 16); bb[bj][n] = *(const f32x4*)(bet + col0 + bj * HALF + n * 16); }
        if (FINAL && TS_SEL && col0 == 0) bb[0][0][0] += dl;
#pragma unroll
        for (int ai = 0; ai < 2; ++ai)
#pragma unroll
            for (int m = 0; m < 4; ++m) { const f32x2 st = Sm[ai * HALF + wr * 64 + m * 16 + fr]; const size_t ro = (size_t)(row0 + ai * HALF + m * 16) * D + col0;
#pragma unroll
                for (int bj = 0; bj < 2; ++bj)
#pragma unroll
                    for (int n = 0; n < 2; ++n) { const f32x4 o = (y[ai][bj][m][n] - st.x) * st.y * gg[bj][n] + bb[bj][n];
                        if (FINAL) *(f32x4*)((float*)O + ro + bj * HALF + n * 16) = o;
                        else { u32x2 w2; w2.x = pko(o[0], o[1]); w2.y = pko(o[2], o[3]); *(u32x2*)((h16*)O + ro + bj * HALF + n * 16) = w2; } } }
    }
};
struct EpiGlu {
    static constexpr bool PERM = true, AFTER_DRAIN = false;
    h16* O;
    __device__ __forceinline__ void operator()(const f32x4 (&acc)[2][2][4][2], const Unit& u, int wr, int wc, int fr, int fq) const {
        const int row0 = u.pm * BM + wr * 64 + fr, col0 = u.pn * HALF + wc * 32 + 8 * fq;
#pragma unroll
        for (int ai = 0; ai < 2; ++ai)
#pragma unroll
            for (int m = 0; m < 4; ++m) { h16* rowp = O + (size_t)(row0 + ai * HALF + m * 16) * FF + col0;
                const f32x4 g0 = acc[ai][0][m][0], g1 = acc[ai][0][m][1], u0 = acc[ai][1][m][0], u1 = acc[ai][1][m][1];
                float r[8];
#pragma unroll
                for (int j = 0; j < 4; ++j) { r[j] = silu_f(g0[j]) * u0[j]; r[4 + j] = silu_f(g1[j]) * u1[j]; }
                u32x4 w; w.x = pko(r[0], r[1]); w.y = pko(r[2], r[3]); w.z = pko(r[4], r[5]); w.w = pko(r[6], r[7]);
                *(u32x4*)rowp = w; }
    }
};
}

template <class RM>
__device__ __forceinline__ void transpose_item(const float* W, int K, int N, h16* WT, LAS float* scr, int item, int lane, RM rm) {
    const int nblk = N / 32, kb = item / nblk, nb = item % nblk, k0 = 64 * kb, n0 = 32 * nb;
    f32x4 v[8];
#pragma unroll
    for (int i = 0; i < 8; ++i) v[i] = __builtin_nontemporal_load((const f32x4*)(W + (size_t)(k0 + (lane >> 3) + 8 * i) * N + n0 + 4 * (lane & 7)));
#pragma unroll
    for (int i = 0; i < 8; ++i) { LAS float* d = scr + ((lane >> 3) + 8 * i) * 33 + 4 * (lane & 7); d[0] = v[i][0]; d[1] = v[i][1]; d[2] = v[i][2]; d[3] = v[i][3]; }
    LDS_WAIT();
    const int c = lane & 7;
#pragma unroll
    for (int j = 0; j < 4; ++j) { const int n = (lane >> 3) + 8 * j; const LAS float* s = scr + (8 * c) * 33 + n;
        u32x4 o; o.x = pko(s[0 * 33], s[1 * 33]); o.y = pko(s[2 * 33], s[3 * 33]); o.z = pko(s[4 * 33], s[5 * 33]); o.w = pko(s[6 * 33], s[7 * 33]);
        *(u32x4*)(WT + (size_t)rm(n0 + n) * K + k0 + 8 * c) = o; }
    LDS_WAIT();
}
struct RmId { __device__ __forceinline__ int operator()(int n) const { return n; } };
struct RmGate { __device__ __forceinline__ int operator()(int n) const { return (n >> 7) * 256 + (n & 127); } };
struct RmUp { __device__ __forceinline__ int operator()(int n) const { return (n >> 7) * 256 + 128 + (n & 127); } };

struct LnAff { f32x4 g[8], b[8]; };
__device__ __forceinline__ void ln_load_aff(LnAff& A, const float* gam, const float* bet, int lane) {
#pragma unroll
    for (int j = 0; j < 8; ++j) { A.g[j] = *((const f32x4*)gam + 64 * j + lane); A.b[j] = *((const f32x4*)bet + 64 * j + lane); }
}
template <bool F32OUT>
__device__ __forceinline__ void ln_row(const float* xrow, const LnAff& A, void* orow, int lane) {
    const f32x4* xr = (const f32x4*)xrow + lane;
    f32x4 v[8]; float s = 0.f;
#pragma unroll
    for (int j = 0; j < 8; ++j) { v[j] = __builtin_nontemporal_load(xr + 64 * j); s += (v[j][0] + v[j][1]) + (v[j][2] + v[j][3]); }
    const float mean = wave_sum(s) * (1.f / D); float s2 = 0.f;
#pragma unroll
    for (int j = 0; j < 8; ++j) { v[j] = v[j] - mean; s2 += (v[j][0] * v[j][0] + v[j][1] * v[j][1]) + (v[j][2] * v[j][2] + v[j][3] * v[j][3]); }
    const float rstd = __builtin_amdgcn_rsqf(wave_sum(s2) * (1.f / D) + LN_EPS);
#pragma unroll
    for (int j = 0; j < 8; ++j) {
        f32x4 y = v[j] * rstd * A.g[j] + A.b[j];
        if (F32OUT) *((f32x4*)orow + 64 * j + lane) = y;
        else { u32x2 w; w.x = pko(y[0], y[1]); w.y = pko(y[2], y[3]); *((u32x2*)orow + 64 * j + lane) = w; }
    }
}

__device__ __forceinline__ void phase0(const Params& p, LAS unsigned char* lds) {
    const int tid = threadIdx.x, lane = tid & 63, wave = tid >> 6, G = gridDim.x;
    const int gw = blockIdx.x * 8 + wave, NGW = G * 8;
    h16* h0 = (h16*)(p.ws + OFF_H0);
    {
        h16* FcT = (h16*)(p.ws + OFF_TAB); h16* F128 = FcT + 512 * 256; h16* G64 = F128 + 256 * 256;
        const int gt = blockIdx.x * 512 + tid, NT = G * 512;
        for (int i = gt; i < 512 * 256; i += NT) { const int nn = i >> 8, c = i & 255, cp = nn >> 1, ri = nn & 1; const float fr = (float)((c * cp) & 255) * (1.f / 256.f);
            FcT[i] = (h16)((ri ? -__builtin_amdgcn_sinf(fr) : __builtin_amdgcn_cosf(fr)) * 0.0625f); }
        for (int i = gt; i < 256 * 256; i += NT) { const int rho = i >> 8, kap = i & 255, ka = rho >> 1, rp = rho & 1, ri = kap >> 7, th = kap & 127; const float fr = (float)((ka * th) & 127) * (1.f / 128.f);
            const float cs = __builtin_amdgcn_cosf(fr), sn = __builtin_amdgcn_sinf(fr); const float v = rp == 0 ? (ri == 0 ? cs : sn) : (ri == 0 ? -sn : cs);
            F128[i] = (h16)(v * 0.08838834764831845f); }
        for (int i = gt; i < 64 * 128; i += NT) { const int kb = i >> 7, kk = i & 127, ri = kk >> 6, tl = kk & 63; const float fr = (float)((kb * tl) & 63) * (1.f / 64.f);
            G64[i] = (h16)((ri ? __builtin_amdgcn_sinf(fr) : __builtin_amdgcn_cosf(fr)) * 0.125f); }
    }
    if (blockIdx.x == 0) { unsigned* c = (unsigned*)(p.ws + OFF_CNT); for (int i = tid; i < 4096 + 64; i += 512) c[i] = 0u; }
    { LnAff A; ln_load_aff(A, p.ln_emb_g, p.ln_emb_b, lane);
      for (int r = gw; r < T; r += NGW) ln_row<false>(p.x + (size_t)r * D, A, h0 + (size_t)r * D, lane); }
    LAS float* scr = (LAS float*)(lds + wave * 8448);
    constexpr int I_IN = (D / 64) * (PW / 32), I_OUT = (D / 64) * (D / 32);
    for (int it = gw; it < I_IN + I_OUT; it += NGW) {
        if (it < I_IN) transpose_item(p.w_in, D, PW, (h16*)(p.ws + OFF_WIN), scr, it, lane, RmId());
        else transpose_item(p.w_out, D, D, (h16*)(p.ws + OFF_WOUT), scr, it - I_IN, lane, RmId());
    }
}

__device__ __forceinline__ void fa_tile(const Params& p, LAS unsigned char* lds, int tile) {
    const int tid = threadIdx.x, lane = tid & 63, w = __builtin_amdgcn_readfirstlane(tid >> 6), r = lane & 15, g = lane >> 4;
    const int t_lo = tile & 63, grp = tile >> 6;
    const h16* U = (const h16*)(p.ws + OFF_U) + 4 * UBLK;
    const h16* FcT = (const h16*)(p.ws + OFF_TAB); const h16* F128 = FcT + 512 * 256;
    h16* Wtw = (h16*)p.out;
    LAS unsigned char* ldsZ = lds + 67584;
#pragma unroll
    for (int i = 0; i < 8; ++i) { const int idx = tid + 512 * i, row = idx >> 5, ch = idx & 31;
        const u32x4 v = *(const u32x4*)(U + (size_t)(t_lo + 64 * row) * 1024 + grp * 256 + ch * 8);
        *(LAS u32x4*)(lds + row * 528 + ch * 16) = v; }
    h16x8 FA3[2][8];
#pragma unroll
    for (int mi = 0; mi < 2; ++mi)
#pragma unroll
        for (int ks = 0; ks < 8; ++ks) FA3[mi][ks] = *(const h16x8*)(F128 + (16 * (2 * w + mi) + r) * 256 + 32 * ks + 8 * g);
    LBAR();
    for (int cb = 0; cb < 4; ++cb) {
        {
            h16x8 Bf[8];
#pragma unroll
            for (int ks = 0; ks < 8; ++ks) Bf[ks] = *(const h16x8*)(FcT + (cb * 128 + 16 * w + r) * 256 + 32 * ks + 8 * g);
            f32x4 acc[8];
#pragma unroll
            for (int mt = 0; mt < 8; ++mt) acc[mt] = (f32x4){0.f, 0.f, 0.f, 0.f};
#pragma unroll
            for (int mt = 0; mt < 8; ++mt)
#pragma unroll
                for (int ks = 0; ks < 8; ++ks) { const h16x8 a = *(const LAS h16x8*)(lds + (16 * mt + r) * 528 + (32 * ks + 8 * g) * 2);
                    acc[mt] = __builtin_amdgcn_mfma_f32_16x16x32_f16(a, Bf[ks], acc[mt], 0, 0, 0); }
            const int n_l = 16 * w + r, zrow = (n_l >> 1) * 264 + (n_l & 1) * 128;
#pragma unroll
            for (int mt = 0; mt < 8; ++mt) { u32x2 o; o.x = pkh(acc[mt][0], acc[mt][1]); o.y = pkh(acc[mt][2], acc[mt][3]);
                *(LAS u32x2*)(ldsZ + (zrow + 16 * mt + 4 * g) * 2) = o; }
        }
        LBAR();
        {
            f32x4 acc3[2][4];
#pragma unroll
            for (int mi = 0; mi < 2; ++mi)
#pragma unroll
                for (int nt = 0; nt < 4; ++nt) acc3[mi][nt] = (f32x4){0.f, 0.f, 0.f, 0.f};
#pragma unroll
            for (int ks = 0; ks < 8; ++ks)
#pragma unroll
                for (int nt = 0; nt < 4; ++nt) { const h16x8 b = *(const LAS h16x8*)(ldsZ + ((16 * nt + r) * 264 + 32 * ks + 8 * g) * 2);
#pragma unroll
                    for (int mi = 0; mi < 2; ++mi) acc3[mi][nt] = __builtin_amdgcn_mfma_f32_16x16x32_f16(FA3[mi][ks], b, acc3[mi][nt], 0, 0, 0); }
#pragma unroll
            for (int mi = 0; mi < 2; ++mi)
#pragma unroll
                for (int pp = 0; pp < 2; ++pp) { const int k_a = 8 * (2 * w + mi) + 2 * g + pp; const float ang = (float)(t_lo * k_a) * (1.f / 8192.f);
                    const float wr_ = __builtin_amdgcn_cosf(ang), wi_ = -__builtin_amdgcn_sinf(ang);
                    h16* dst = Wtw + ((((size_t)t_lo * 128 + k_a) * 4 + grp) * 256 + cb * 64 + r) * 2;
#pragma unroll
                    for (int nt = 0; nt < 4; ++nt) { const float re = acc3[mi][nt][2 * pp], im = acc3[mi][nt][2 * pp + 1];
                        *(unsigned*)(dst + nt * 32) = pkh(re * wr_ - im * wi_, re * wi_ + im * wr_); } }
        }
        LBAR();
    }
}

__device__ __forceinline__ void fb_tile(const Params& p, LAS unsigned char* lds, int tile, const h16x8 (&Bg)[4][4]) {
    const int tid = threadIdx.x, lane = tid & 63, w = __builtin_amdgcn_readfirstlane(tid >> 6), r = lane & 15, g = lane >> 4;
    const int k_a = tile & 127, grp = tile >> 7;
    const h16* Wtw = (const h16*)p.out;
    h16* mix = (h16*)(p.ws + OFF_MIX);
    LAS h16* ldsW = (LAS h16*)lds;
#pragma unroll
    for (int i = 0; i < 8; ++i) { const int mm = w * 8 + i, t_lo = 16 * (mm & 3) + (tid & 15), ch = 4 * (mm >> 2) + ((tid >> 4) & 3);
        const h16x8 v = *(const h16x8*)(Wtw + ((((size_t)t_lo * 128 + k_a) * 4 + grp) * 256 + 4 * ch) * 2);
#pragma unroll
        for (int q = 0; q < 4; ++q) { ldsW[(4 * ch + q) * 136 + t_lo] = v[2 * q]; ldsW[(4 * ch + q) * 136 + 64 + t_lo] = v[2 * q + 1]; } }
    LBAR();
    f32x4 acc[2][4];
#pragma unroll
    for (int mi = 0; mi < 2; ++mi)
#pragma unroll
        for (int nt = 0; nt < 4; ++nt) acc[mi][nt] = (f32x4){0.f, 0.f, 0.f, 0.f};
#pragma unroll
    for (int ks = 0; ks < 4; ++ks)
#pragma unroll
        for (int mi = 0; mi < 2; ++mi) { const h16x8 a = *(const LAS h16x8*)(ldsW + (16 * (2 * w + mi) + r) * 136 + 32 * ks + 8 * g);
#pragma unroll
            for (int nt = 0; nt < 4; ++nt) acc[mi][nt] = __builtin_amdgcn_mfma_f32_16x16x32_f16(a, Bg[nt][ks], acc[mi][nt], 0, 0, 0); }
#pragma unroll
    for (int mi = 0; mi < 2; ++mi)
#pragma unroll
        for (int nt = 0; nt < 4; ++nt) { const int tp = k_a + 128 * (16 * nt + r); u32x2 o; o.x = pko(acc[mi][nt][0], acc[mi][nt][1]); o.y = pko(acc[mi][nt][2], acc[mi][nt][3]);
            *(u32x2*)(mix + (size_t)tp * D + 1024 + grp * 256 + 16 * (2 * w + mi) + 4 * g) = o; }
    LBAR();
}

__device__ __forceinline__ void prep_item(const Params& p, LAS unsigned char* lds, int item) {
    const int tid = threadIdx.x, lane = tid & 63, w = __builtin_amdgcn_readfirstlane(tid >> 6), r = lane & 15, g = lane >> 4;
    const int n = item & 127, h = (item >> 7) & 7, d = item >> 10;
    const h16* ub = (const h16*)(p.ws + OFF_U);
    const h16* uq = ub, *uv = ub + UBLK, *uz = ub + (size_t)(2 + d) * UBLK;
    unsigned char* rec = p.ws + OFF_PQ + (size_t)item * REC_BYTES;
    h16* vfr = (h16*)((unsigned char*)p.out + 32 * MiB + (size_t)item * 16384);
    float* dec = (float*)(p.ws + OFF_DEC) + (size_t)item * 128;
    LAS unsigned short* Qb = (LAS unsigned short*)lds;
    LAS unsigned short* KIb = (LAS unsigned short*)(lds + 17408);
    LAS h16* Qh = (LAS h16*)(lds + 34816);
    LAS float* segtot = (LAS float*)(lds + 52224);
    LAS h16* KEt = (LAS h16*)(lds + 60416);
    LAS h16* Vt = (LAS h16*)(lds + 78848);
    const int kq = tid & 31, seg = tid >> 5, ch = h * 128 + 4 * kq;
    const float* lbl = d ? p.lbb : p.lbf;
    f32x4 lb;
    { const f32x4 l0 = *(const f32x4*)(lbl + ch), l1 = *(const f32x4*)(lbl + 1024 + ch);
#pragma unroll
      for (int c = 0; c < 4; ++c) lb[c] = __builtin_amdgcn_rcpf(1.0f + __expf(l1[c] - l0[c])); }
    h16x4 zr[4], qr[4], vr[4];
#pragma unroll
    for (int jj = 0; jj < 4; ++jj) { const int tau = 64 * n + 4 * seg + jj, t = d ? (T - 1 - tau) : tau; const size_t o = (size_t)t * 1024 + ch;
        zr[jj] = *(const h16x4*)(uz + o); qr[jj] = *(const h16x4*)(uq + o); vr[jj] = *(const h16x4*)(uv + o); }
    f32x4 bc[4], kk[4], run = (f32x4){0.f, 0.f, 0.f, 0.f};
#pragma unroll
    for (int jj = 0; jj < 4; ++jj)
#pragma unroll
        for (int c = 0; c < 4; ++c) { const float z = (float)zr[jj][c];
            const float sg = __builtin_amdgcn_rcpf(1.0f + __expf(-z));
            const float f = lb[c] + (1.0f - lb[c]) * sg;
            run[c] += __logf(f); bc[jj][c] = run[c]; kk[jj][c] = 1.0f - f; }
    *(LAS f32x4*)(segtot + seg * 128 + 4 * kq) = run;
    LBAR();
    f32x4 pre = (f32x4){0.f, 0.f, 0.f, 0.f}, tot = (f32x4){0.f, 0.f, 0.f, 0.f};
#pragma unroll
    for (int sI = 0; sI < 16; ++sI) { const f32x4 v = *(const LAS f32x4*)(segtot + sI * 128 + 4 * kq); tot += v; if (sI < seg) pre += v; }
    if (seg == 0) *(f32x4*)(dec + 4 * kq) = tot;
    {
        float kef[4][4];
#pragma unroll
        for (int jj = 0; jj < 4; ++jj) { const int j = 4 * seg + jj; float qd[4], ki[4];
#pragma unroll
            for (int c = 0; c < 4; ++c) { const float b = pre[c] + bc[jj][c];
                qd[c] = (float)qr[jj][c] * __expf(b); ki[c] = kk[jj][c] * __expf(-b); kef[c][jj] = kk[jj][c] * __expf(tot[c] - b); }
            u32x2 qb2, kb2, qh2;
            qb2.x = (unsigned)f2bf(qd[0]) | ((unsigned)f2bf(qd[1]) << 16); qb2.y = (unsigned)f2bf(qd[2]) | ((unsigned)f2bf(qd[3]) << 16);
            kb2.x = (unsigned)f2bf(ki[0]) | ((unsigned)f2bf(ki[1]) << 16); kb2.y = (unsigned)f2bf(ki[2]) | ((unsigned)f2bf(ki[3]) << 16);
            qh2.x = pkh(qd[0], qd[1]); qh2.y = pkh(qd[2], qd[3]);
            *(LAS u32x2*)(Qb + j * 136 + 4 * kq) = qb2; *(LAS u32x2*)(KIb + j * 136 + 4 * kq) = kb2; *(LAS u32x2*)(Qh + j * 136 + 4 * kq) = qh2; }
#pragma unroll
        for (int c = 0; c < 4; ++c) { u32x2 ke2; ke2.x = pkh(kef[c][0], kef[c][1]); ke2.y = pkh(kef[c][2], kef[c][3]);
            h16x4 v4; v4[0] = vr[0][c]; v4[1] = vr[1][c]; v4[2] = vr[2][c]; v4[3] = vr[3][c];
            *(LAS u32x2*)(KEt + (4 * kq + c) * 72 + 4 * seg) = ke2;
            *(LAS u32x2*)(Vt + (4 * kq + c) * 72 + 4 * seg) = __builtin_bit_cast(u32x2, v4); }
    }
    LBAR();
#pragma unroll
    for (int i = 0; i < 2; ++i) { const int sl = tid + 512 * i, lp = sl & 63, blk = sl >> 6, kk2 = 16 * (blk >> 1) + (lp & 15), s0 = 32 * (blk & 1) + 8 * (lp >> 4);
        *(u32x4*)(rec + 24576 + (size_t)sl * 16) = *(const LAS u32x4*)(KEt + kk2 * 72 + s0);
        *(u32x4*)((unsigned char*)vfr + (size_t)sl * 16) = *(const LAS u32x4*)(Vt + kk2 * 72 + s0); }
#pragma unroll
    for (int i = 0; i < 2; ++i) { const int sl = tid + 512 * i, lp = sl & 63, jp = (sl >> 6) & 1, wq = sl >> 7, rr = lp & 15, gg = lp >> 4;
        u32x4 v; const u32x2 v0 = *(const LAS u32x2*)(Qh + (32 * jp + rr) * 136 + 16 * wq + 4 * gg), v1 = *(const LAS u32x2*)(Qh + (32 * jp + 16 + rr) * 136 + 16 * wq + 4 * gg);
        v.x = v0.x; v.y = v0.y; v.z = v1.x; v.w = v1.y;
        *(u32x4*)(rec + 8192 + (size_t)sl * 16) = v;
    }
    {
        const int jt = w >> 1;
#pragma unroll
        for (int si = 0; si < 2; ++si) { const int st = 2 * (w & 1) + si;
            f32x4 a4 = (f32x4){0.f, 0.f, 0.f, 0.f};
            if (st <= jt) {
#pragma unroll
                for (int ks = 0; ks < 4; ++ks) { const s16x8 a = *(const LAS s16x8*)(KIb + (16 * st + r) * 136 + 32 * ks + 8 * g); const s16x8 b = *(const LAS s16x8*)(Qb + (16 * jt + r) * 136 + 32 * ks + 8 * g);
                    a4 = __builtin_amdgcn_mfma_f32_16x16x32_bf16(__builtin_bit_cast(__bf16 __attribute__((ext_vector_type(8))), a), __builtin_bit_cast(__bf16 __attribute__((ext_vector_type(8))), b), a4, 0, 0, 0); }
            }
            const int j = 16 * jt + r;
#pragma unroll
            for (int i = 0; i < 4; ++i) { const int s = 16 * st + 4 * g + i; if (s > j) a4[i] = 0.f; }
            u32x2 o; o.x = pkh(a4[0], a4[1]); o.y = pkh(a4[2], a4[3]);
            const int lp = (2 * (st & 1) + (g >> 1)) * 16 + r;
            *(u32x2*)(rec + ((size_t)(jt * 2 + (st >> 1)) * 64 + lp) * 16 + 8 * (g & 1)) = o; }
    }
    LBAR();
}

struct StepLd { h16x8 ke0, ke1, bv0, bv1, pf, q01, q23; f32x4 dec; };
__device__ __forceinline__ void scan_load(StepLd& L, const unsigned char* rec0, const unsigned char* vf0, const float* dec0, int n, int w, int lane, int vs) {
    n = n < 127 ? n : 127;
    const unsigned char* rec = rec0 + (size_t)n * REC_BYTES;
    L.pf = *(const h16x8*)(rec + ((size_t)((w & 3) * 2 + (w >> 2)) * 64 + lane) * 16);
    L.q01 = *(const h16x8*)(rec + 8192 + ((size_t)(w * 2 + 0) * 64 + lane) * 16);
    L.q23 = *(const h16x8*)(rec + 8192 + ((size_t)(w * 2 + 1) * 64 + lane) * 16);
    L.ke0 = *(const h16x8*)(rec + 24576 + ((size_t)(w * 2 + 0) * 64 + lane) * 16);
    L.ke1 = *(const h16x8*)(rec + 24576 + ((size_t)(w * 2 + 1) * 64 + lane) * 16);
    if (w == 0) {
        const unsigned char* vf = vf0 + (size_t)n * 16384;
        L.bv0 = *(const h16x8*)(vf + ((size_t)(vs * 2 + 0) * 64 + lane) * 16);
        L.bv1 = *(const h16x8*)(vf + ((size_t)(vs * 2 + 1) * 64 + lane) * 16);
    }
    L.dec = *(const f32x4*)(dec0 + (size_t)n * 128 + 16 * w + 4 * (lane >> 4));
}
__device__ __forceinline__ void scan_step(const StepLd& L, const StepLd& Lnext, f32x4& S, f32x4& Bc, float* cumb, LAS unsigned char* lds, h16* od, int n, int d, int w, int lane, int vs) {
    const h16x4 sb = __builtin_convertvector(S, h16x4);
    f32x4 o[4];
    o[0] = __builtin_amdgcn_mfma_f32_16x16x16f16(sb, __builtin_shufflevector(L.q01, L.q01, 0, 1, 2, 3), (f32x4){0.f, 0.f, 0.f, 0.f}, 0, 0, 0);
    o[1] = __builtin_amdgcn_mfma_f32_16x16x16f16(sb, __builtin_shufflevector(L.q01, L.q01, 4, 5, 6, 7), (f32x4){0.f, 0.f, 0.f, 0.f}, 0, 0, 0);
    o[2] = __builtin_amdgcn_mfma_f32_16x16x16f16(sb, __builtin_shufflevector(L.q23, L.q23, 0, 1, 2, 3), (f32x4){0.f, 0.f, 0.f, 0.f}, 0, 0, 0);
    o[3] = __builtin_amdgcn_mfma_f32_16x16x16f16(sb, __builtin_shufflevector(L.q23, L.q23, 4, 5, 6, 7), (f32x4){0.f, 0.f, 0.f, 0.f}, 0, 0, 0);
    LAS unsigned char* vsl = lds + 65536 + (n & 1) * 2048;
    const h16x8 bv0 = *(const LAS h16x8*)(vsl + lane * 16), bv1 = *(const LAS h16x8*)(vsl + 1024 + lane * 16);
    const h16x8 bvp = (w >> 2) ? bv1 : bv0;
#pragma unroll
    for (int jt = 0; jt < 4; ++jt) if (jt == (w & 3)) o[jt] = __builtin_amdgcn_mfma_f32_16x16x32_f16(bvp, L.pf, o[jt], 0, 0, 0);
    if (vs == 0) *(f32x4*)(cumb + (size_t)n * 128 + 16 * w + 4 * (lane >> 4)) = Bc;
    Bc += L.dec;
    { f32x4 dk; dk[0] = __expf(L.dec[0]); dk[1] = __expf(L.dec[1]); dk[2] = __expf(L.dec[2]); dk[3] = __expf(L.dec[3]); S = S * dk; }
    S = __builtin_amdgcn_mfma_f32_16x16x32_f16(L.ke0, bv0, S, 0, 0, 0);
    S = __builtin_amdgcn_mfma_f32_16x16x32_f16(L.ke1, bv1, S, 0, 0, 0);
    if (w == 0) { LAS unsigned char* vn = lds + 65536 + ((n + 1) & 1) * 2048; *(LAS h16x8*)(vn + lane * 16) = Lnext.bv0; *(LAS h16x8*)(vn + 1024 + lane * 16) = Lnext.bv1; }
    LAS unsigned char* pb = lds + (n & 1) * 32768;
#pragma unroll
    for (int jt = 0; jt < 4; ++jt) *(LAS f32x4*)(pb + ((w * 4 + jt) * 64 + lane) * 16) = o[jt];
    asm volatile("s_waitcnt lgkmcnt(0)" ::: "memory"); __builtin_amdgcn_s_barrier(); asm volatile("" ::: "memory");
    if (w < 4) {
        f32x4 tot = (f32x4){0.f, 0.f, 0.f, 0.f};
#pragma unroll
        for (int ww = 0; ww < 8; ++ww) tot += *(const LAS f32x4*)(pb + ((ww * 4 + w) * 64 + lane) * 16);
        const int r = lane & 15, g = lane >> 4, tau = 64 * n + 16 * w + r, t = d ? (T - 1 - tau) : tau;
        *(h16x4*)(od + (size_t)t * 1024 + 4 * g) = __builtin_convertvector(tot, h16x4);
    }
}
__device__ __forceinline__ void scan_job(const Params& p, LAS unsigned char* lds, int job) {
    const int tid = threadIdx.x, lane = tid & 63, w = __builtin_amdgcn_readfirstlane(tid >> 6);
    const int idx = job >> 3, vs = idx & 7, pair = (job & 7) * 4 + (idx >> 3), hd = pair >> 1, sg = pair & 1, h = hd & 7, d = hd >> 3;
    const size_t item0 = (size_t)hd * 128;
    const unsigned char* rec0 = p.ws + OFF_PQ + item0 * REC_BYTES;
    const unsigned char* vf0 = (const unsigned char*)p.out + 32 * MiB + item0 * 16384;
    const float* dec0 = (const float*)(p.ws + OFF_DEC) + item0 * 128;
    float* cumb = (float*)(p.ws + OFF_CUMB) + item0 * 128;
    h16* od = (h16*)(p.ws + OFF_ODIR) + (size_t)d * T * 1024 + h * 128 + vs * 16;
    f32x4 S = (f32x4){0.f, 0.f, 0.f, 0.f}, Bc = (f32x4){0.f, 0.f, 0.f, 0.f};
    StepLd b0, b1, b2, b3;
    const int n0 = 64 * sg;
    scan_load(b0, rec0, vf0, dec0, n0, w, lane, vs); asm volatile("" ::: "memory"); scan_load(b1, rec0, vf0, dec0, n0 + 1, w, lane, vs); asm volatile("" ::: "memory"); scan_load(b2, rec0, vf0, dec0, n0 + 2, w, lane, vs); asm volatile("" ::: "memory");
    if (w == 0) { LAS unsigned char* vn = lds + 65536 + (n0 & 1) * 2048; *(LAS h16x8*)(vn + lane * 16) = b0.bv0; *(LAS h16x8*)(vn + 1024 + lane * 16) = b0.bv1; }
    LBAR();
    for (int n = n0; n < n0 + 64; n += 4) {
        scan_load(b3, rec0, vf0, dec0, n + 3, w, lane, vs); scan_step(b0, b1, S, Bc, cumb, lds, od, n, d, w, lane, vs);
        scan_load(b0, rec0, vf0, dec0, n + 4, w, lane, vs); scan_step(b1, b2, S, Bc, cumb, lds, od, n + 1, d, w, lane, vs);
        scan_load(b1, rec0, vf0, dec0, n + 5, w, lane, vs); scan_step(b2, b3, S, Bc, cumb, lds, od, n + 2, d, w, lane, vs);
        scan_load(b2, rec0, vf0, dec0, n + 6, w, lane, vs); scan_step(b3, b0, S, Bc, cumb, lds, od, n + 3, d, w, lane, vs);
    }
    if (sg == 0) *(h16x4*)(p.ws + OFF_SFIN + ((size_t)((hd * 8 + w) * 8 + vs) * 64 + lane) * 8) = __builtin_convertvector(S, h16x4);
    LBAR();
}

__device__ __forceinline__ void phase4(const Params& p, LAS unsigned char* lds) {
    const int tid = threadIdx.x, lane = tid & 63, wave = tid >> 6, G = gridDim.x;
    const int gw = blockIdx.x * 8 + wave, NGW = G * 8;
    const h16* of = (const h16*)(p.ws + OFF_ODIR); const h16* ob = of + (size_t)T * 1024;
    const h16* ug = (const h16*)(p.ws + OFF_U) + 5 * UBLK;
    h16* mix = (h16*)(p.ws + OFF_MIX);
    const f32x2 gn = *((const f32x2*)p.g_norm + lane);
    {
        const int w = __builtin_amdgcn_readfirstlane(wave), r = lane & 15, g = lane >> 4, jt = w >> 1, vh = w & 1;
        LAS float* F = (LAS float*)lds;
        for (int unit = blockIdx.x; unit < 1024; unit += G) {
            const int nb = unit >> 3, h = unit & 7, dd = nb < 64 ? 1 : 0, n = dd ? 127 - nb : nb, hd = dd * 8 + h;
            const size_t item = (size_t)hd * 128 + n;
            const unsigned char* qf = p.ws + OFF_PQ + item * REC_BYTES + 8192;
            const float* cumb = (const float*)(p.ws + OFF_CUMB) + item * 128;
            const unsigned char* sf = p.ws + OFF_SFIN + (size_t)hd * 8 * 8 * 512;
            h16x4 qa[8]; f32x4 bc[8]; h16x4 sb[8][4];
            h16x2 a[8], b[8]; h16x2 gv[8];
#pragma unroll
            for (int rr = 0; rr < 8; ++rr) { const size_t o = (size_t)(64 * nb + 8 * w + rr) * 1024 + h * 128 + 2 * lane;
                a[rr] = *(const h16x2*)(of + o); b[rr] = *(const h16x2*)(ob + o); gv[rr] = *(const h16x2*)(ug + o); }
#pragma unroll
            for (int wp = 0; wp < 8; ++wp) { qa[wp] = *(const h16x4*)(qf + ((size_t)(wp * 2 + (jt >> 1)) * 64 + lane) * 16 + (jt & 1) * 8); bc[wp] = *(const f32x4*)(cumb + 16 * wp + 4 * g);
#pragma unroll
                for (int v4 = 0; v4 < 4; ++v4) sb[wp][v4] = *(const h16x4*)(sf + ((size_t)(wp * 8 + 4 * vh + v4) * 64 + lane) * 8); }
            f32x4 acc[4];
#pragma unroll
            for (int v4 = 0; v4 < 4; ++v4) acc[v4] = (f32x4){0.f, 0.f, 0.f, 0.f};
#pragma unroll
            for (int wp = 0; wp < 8; ++wp) { h16x4 a;
#pragma unroll
                for (int i = 0; i < 4; ++i) a[i] = (h16)((float)qa[wp][i] * __expf(bc[wp][i]));
#pragma unroll
                for (int v4 = 0; v4 < 4; ++v4) acc[v4] = __builtin_amdgcn_mfma_f32_16x16x16f16(a, sb[wp][v4], acc[v4], 0, 0, 0); }
#pragma unroll
            for (int v4 = 0; v4 < 4; ++v4)
#pragma unroll
                for (int i = 0; i < 4; ++i) { const int j = 16 * jt + 4 * g + i, rho = dd ? 63 - j : j; F[rho * 132 + 16 * (4 * vh + v4) + r] = acc[v4][i]; }
            LBAR();
            f32x2 fx[8];
#pragma unroll
            for (int rr = 0; rr < 8; ++rr) fx[rr] = *(const LAS f32x2*)(F + (8 * w + rr) * 132 + 2 * lane);
#pragma unroll
            for (int rr = 0; rr < 8; ++rr) { const int t = 64 * nb + 8 * w + rr; const float o0 = (float)a[rr].x + (float)b[rr].x + fx[rr].x, o1 = (float)a[rr].y + (float)b[rr].y + fx[rr].y;
                const float ss = wave_sum(o0 * o0 + o1 * o1); const float rs = __builtin_amdgcn_rsqf(ss * (1.f / 128.f) + RMS_EPS);
                *(unsigned*)(mix + (size_t)t * D + h * 128 + 2 * lane) = pko(o0 * rs * gn.x * (float)gv[rr].x, o1 * rs * gn.y * (float)gv[rr].y); }
            LBAR();
        }
    }
    LAS float* scr = (LAS float*)(lds + wave * 8448);
    constexpr int I_G = (D / 64) * (FF / 32);
    for (int it = gw; it < 2 * I_G; it += NGW) {
        if (it < I_G) transpose_item(p.w_gate, D, FF, (h16*)p.out, scr, it, lane, RmGate());
        else transpose_item(p.w_up, D, FF, (h16*)p.out, scr, it - I_G, lane, RmUp());
    }
}
__device__ __forceinline__ void wdown_transposes(const Params& p, LAS unsigned char* lds, unsigned* ctr) {
    const int tid = threadIdx.x, lane = tid & 63, wave = tid >> 6;
    LAS float* scr = (LAS float*)(lds + wave * 8448);
    constexpr int I_D = (FF / 64) * (D / 32), NCH = I_D / 4;
    for (;;) {
        unsigned ch = 0u; if (lane == 0) ch = __hip_atomic_fetch_add(ctr, 1u, __ATOMIC_RELAXED, __HIP_MEMORY_SCOPE_AGENT);
        ch = (unsigned)__builtin_amdgcn_readfirstlane((int)ch);
        if (ch >= (unsigned)NCH) break;
#pragma unroll 1
        for (int k = 0; k < 4; ++k) transpose_item(p.w_down, FF, D, (h16*)(p.ws + OFF_WD), scr, (int)ch * 4 + k, lane, RmId());
    }
}

#define XB_TMO      128
#define XB_XCNT(j)  (256  + 64 * (j))
#define XB_XSUB(j)  (1280 + 64 * (j))
#define XB_XGEN(j)  (2304 + 64 * (j))
#define XB_TOP      3328
#define XB_TOPGEN   3392
#define XCD_BAR_WORDS 3456
#define XB_SPIN_CAP (1u << 22)
__device__ __forceinline__ unsigned xb_ld(unsigned* p)              { return __hip_atomic_load(p, __ATOMIC_RELAXED, __HIP_MEMORY_SCOPE_AGENT); }
__device__ __forceinline__ unsigned xb_add(unsigned* p, unsigned v) { return __hip_atomic_fetch_add(p, v, __ATOMIC_RELAXED, __HIP_MEMORY_SCOPE_AGENT); }
__device__ __forceinline__ unsigned xb_xcc_id() { return (unsigned)__builtin_amdgcn_s_getreg((3 << 11) | 20) & 0xFu; }
#define XB_SPIN(cond, bar) do { unsigned _sp = 0; while (cond) { __builtin_amdgcn_s_sleep(1); \
    if ((++_sp & 255u) == 0u) { if (xb_ld(&(bar)[XB_TMO])) break; if (_sp > XB_SPIN_CAP) { atomicAdd(&(bar)[XB_TMO], 1u); break; } } } } while (0)
__device__ __forceinline__ void xcd_barrier(unsigned* bar, unsigned x, volatile LAS unsigned* st) {
    asm volatile("s_waitcnt vmcnt(0) lgkmcnt(0)" ::: "memory");
    __builtin_amdgcn_s_barrier();
    if (threadIdx.x == 0) {
        unsigned nloc = st[0], nx = st[1];
        if (nloc == 0u) {
            const unsigned G = gridDim.x; unsigned sum, cnt, mine, sp = 0u;
            for (;;) { sum = 0u; cnt = 0u; mine = 0u;
#pragma unroll
                for (unsigned j = 0; j < 16; ++j) { const unsigned c = xb_ld(&bar[XB_XCNT(j)]); sum += c; cnt += (c > 0u) ? 1u : 0u; mine = (j == x) ? c : mine; }
                if (sum == G) break;
                __builtin_amdgcn_s_sleep(1);
                if ((++sp & 255u) == 0u) { if (xb_ld(&bar[XB_TMO])) break; if (sp > XB_SPIN_CAP) { atomicAdd(&bar[XB_TMO], 1u); break; } } }
            nloc = mine > 0u ? mine : 1u; nx = cnt > 0u ? cnt : 1u; st[0] = nloc; st[1] = nx; }
        const unsigned old = xb_add(&bar[XB_XSUB(x)], 1u);
        const unsigned gen = old / nloc;
        if (old + 1u == (gen + 1u) * nloc) {
            __builtin_amdgcn_fence(__ATOMIC_RELEASE, "agent");
            asm volatile("s_waitcnt vmcnt(0)" ::: "memory");
            const unsigned og = xb_add(&bar[XB_TOP], 1u);
            const unsigned tg = og / nx;
            if (og + 1u == (tg + 1u) * nx) xb_add(&bar[XB_TOPGEN], 1u);
            else XB_SPIN(xb_ld(&bar[XB_TOPGEN]) == tg, bar);
            __builtin_amdgcn_fence(__ATOMIC_ACQUIRE, "agent");
            xb_add(&bar[XB_XGEN(x)], 1u);
            asm volatile("s_waitcnt vmcnt(0)" ::: "memory");
        } else {
            XB_SPIN(xb_ld(&bar[XB_XGEN(x)]) == gen, bar);
            __builtin_amdgcn_fence(__ATOMIC_ACQUIRE, "agent");
            asm volatile("s_waitcnt vmcnt(0)" ::: "memory");
        }
    }
    asm volatile("s_waitcnt lgkmcnt(0)" ::: "memory");
    __builtin_amdgcn_s_barrier();
    asm volatile("" ::: "memory");
}

__global__ void __launch_bounds__(512, 2) fwd_megakernel(Params p) {
    extern __shared__ __attribute__((aligned(16))) unsigned char shm[];
    LAS unsigned char* lds = (LAS unsigned char*)shm;
    const int G = gridDim.x, bid = blockIdx.x, tid = threadIdx.x, lane = tid & 63, wave = tid >> 6;
    const int gw = bid * 8 + wave, NGW = G * 8;
#ifndef PROBE_MASK
#define PROBE_MASK 0
#endif
#define RUN(ph) if (p.ph_lo <= (ph) && (ph) < p.ph_hi)
#define TSWB(i, b) do { if (TS_SEL && bid == (b) && tid == 0) ((unsigned long long*)(p.ws + OFF_TAB + 600 * 1024))[i] = __builtin_amdgcn_s_memrealtime(); } while (0)
#define TSW(i) do { if (TS_SEL && bid == 0 && tid == 0) ((unsigned long long*)(p.ws + OFF_TAB + 600 * 1024))[i] = __builtin_amdgcn_s_memrealtime(); } while (0)
    unsigned* const xbar = (unsigned*)(p.ws + OFF_BAR);
    const unsigned xcc = xb_xcc_id();
    volatile LAS unsigned* const xst = (volatile LAS unsigned*)(lds + 131072);
    if (p.ph_hi - p.ph_lo > 1) { if (tid == 0) { xst[0] = 0u; xst[1] = 0u; (void)xb_add(&xbar[XB_XCNT(xcc)], 1u); } LBAR(); }
    if (p.ph_hi > 1000) cg::this_grid().sync();
#define SYNC(ph) do { if (p.ph_lo < (ph) && (ph) < p.ph_hi) { xcd_barrier(xbar, xcc, xst); TSW(ph); } } while (0)
    TSW(0);
    RUN(0) phase0(p, lds);
    SYNC(1);
    RUN(1) { pg8::Gemm g{(const h16*)(p.ws + OFF_H0), (const h16*)(p.ws + OFF_WIN), T, PW, D}; pg8::StaticOrder S; S.init(T, PW, G, bid);
        S.ctr = (unsigned*)(p.ws + OFF_CNT) + 4096 + 16; pg8::EpiU E{(h16*)(p.ws + OFF_U)}; pg8::gemm_phase<pg8::EpiU, true>(lds, g, S, E); }
    SYNC(2);
    RUN(2) {
        for (int tile = bid; tile < 256; tile += G) fa_tile(p, lds, tile);
        TSWB(12, 0);
        for (int pr = bid; pr < 1024; pr += G) { const int nb = pr & 127, h = pr >> 7;
            prep_item(p, lds, (0 * 8 + h) * 128 + nb); prep_item(p, lds, (1 * 8 + h) * 128 + 127 - nb); }
    }
    SYNC(3);
    RUN(3) {
        for (int job = bid; job < 256; job += G) scan_job(p, lds, job);
        TSWB(10, 0);
        {
            const int r = lane & 15, g = lane >> 4;
            const h16* G64 = (const h16*)(p.ws + OFF_TAB) + 512 * 256 + 256 * 256;
            h16x8 Bg[4][4];
#pragma unroll
            for (int nt = 0; nt < 4; ++nt)
#pragma unroll
                for (int ks = 0; ks < 4; ++ks) Bg[nt][ks] = *(const h16x8*)(G64 + (16 * nt + r) * 128 + 32 * ks + 8 * g);
            for (int tile = bid; tile < 512; tile += G) fb_tile(p, lds, tile, Bg);
            TSWB(11, 255);
        }
    }
    SYNC(4);
    RUN(4) phase4(p, lds);
    SYNC(5);
    RUN(5) { pg8::Gemm g{(const h16*)(p.ws + OFF_MIX), (const h16*)(p.ws + OFF_WOUT), T, D, D}; pg8::StaticOrder S; S.init(T, D, G, bid);
        pg8::EpiLn<false> E{(const h16*)(p.ws + OFF_H0), (void*)(p.ws + OFF_H0), p.ln1_g, p.ln1_b, (float*)(p.ws + OFF_XB5), (unsigned*)(p.ws + OFF_CNT)}; pg8::gemm_phase(lds, g, S, E); }
    SYNC(7);
    RUN(7) { pg8::Gemm g{(const h16*)(p.ws + OFF_H0), (const h16*)p.out, T, 2 * FF, D}; pg8::StaticOrder S; S.init(T, 2 * FF, G, bid);
        S.ctr = (unsigned*)(p.ws + OFF_CNT) + 4096 + 32; pg8::EpiGlu E{(h16*)(p.ws + OFF_ACT)}; pg8::gemm_phase<pg8::EpiGlu, true>(lds, g, S, E);
        wdown_transposes(p, lds, (unsigned*)(p.ws + OFF_CNT) + 4096 + 48); }
    SYNC(8);
    RUN(8) { pg8::Gemm g{(const h16*)(p.ws + OFF_ACT), (const h16*)(p.ws + OFF_WD), T, D, FF}; pg8::StaticOrder S; S.init(T, D, G, bid);
        pg8::EpiLn<true> E{(const h16*)(p.ws + OFF_H0), (void*)p.out, p.ln2_g, p.ln2_b, (float*)(p.ws + OFF_XB8), (unsigned*)(p.ws + OFF_CNT) + 2048}; pg8::gemm_phase(lds, g, S, E); }
}

extern "C" void kernel_launch(void* const* d_in, const int* in_sizes, int n_in, void* d_out, int out_size, void* d_ws, size_t ws_size, hipStream_t stream) {
    static int grid = 0;
    if (grid == 0) {
        if (n_in != 15 || in_sizes[0] != T * D || out_size != T * D || ws_size < WS_NEED) { fprintf(stderr, "kernel_launch: unexpected shapes (n_in %d in0 %d out %d ws %zu)\n", n_in, n_in > 0 ? in_sizes[0] : -1, out_size, ws_size); grid = -1; return; }
        int dev = 0, cus = 0, per_cu = 0;
        hipGetDevice(&dev); hipDeviceGetAttribute(&cus, hipDeviceAttributeMultiprocessorCount, dev);
        if (hipFuncSetAttribute((const void*)fwd_megakernel, hipFuncAttributeMaxDynamicSharedMemorySize, LDS_BYTES) != hipSuccess) { fprintf(stderr, "kernel_launch: hipFuncSetAttribute failed\n"); grid = -1; return; }
        if (hipOccupancyMaxActiveBlocksPerMultiprocessor(&per_cu, (const void*)fwd_megakernel, 512, LDS_BYTES) != hipSuccess || per_cu < 1) { fprintf(stderr, "kernel_launch: occupancy query gave %d\n", per_cu); per_cu = 1; }
        (void)hipGetLastError();
        grid = cus * 1;
        if (grid > 256) grid = 256;
        if (grid != 256) { fprintf(stderr, "kernel_launch: the fused LayerNorm epilogues need exactly 256 workgroups (one per CU); device has %d CUs\n", cus); grid = -1; return; }
    }
    if (grid < 0) return;
    Params p{};
    p.x = (const float*)d_in[0]; p.ln_emb_g = (const float*)d_in[1]; p.ln_emb_b = (const float*)d_in[2]; p.w_in = (const float*)d_in[3];
    p.lbf = (const float*)d_in[4]; p.lbb = (const float*)d_in[5]; p.g_norm = (const float*)d_in[6]; p.w_out = (const float*)d_in[7];
    p.ln1_g = (const float*)d_in[8]; p.ln1_b = (const float*)d_in[9]; p.w_gate = (const float*)d_in[10]; p.w_up = (const float*)d_in[11];
    p.w_down = (const float*)d_in[12]; p.ln2_g = (const float*)d_in[13]; p.ln2_b = (const float*)d_in[14];
    p.out = (float*)d_out; p.ws = (unsigned char*)d_ws;
#if N_LAUNCH_MODE == 1
    if (hipMemsetAsync((unsigned char*)d_ws + OFF_BAR, 0, XCD_BAR_WORDS * 4, stream) != hipSuccess) { fprintf(stderr, "kernel_launch: hipMemsetAsync failed\n"); return; }
    p.ph_lo = 0; p.ph_hi = 10;
    void* args[] = {&p};
    hipError_t e = hipLaunchCooperativeKernel((const void*)fwd_megakernel, dim3(grid), dim3(512), args, LDS_BYTES, stream);
    if (e != hipSuccess) fprintf(stderr, "cooperative launch failed: %s (grid %d)\n", hipGetErrorString(e), grid);
#else
    for (int ph = 0; ph < 10; ++ph) for (int rp = 0; rp < 1 + ((PROBE_MASK >> ph) & 1); ++rp) { p.ph_lo = ph; p.ph_hi = ph + 1; hipLaunchKernelGGL(fwd_megakernel, dim3(grid), dim3(512), LDS_BYTES, stream, p); }
#endif
}
```

```cpp
#include <hip/hip_runtime.h>
#include <hip/hip_cooperative_groups.h>
#include <cstdio>
#include <cstdint>
namespace cg = cooperative_groups;

#ifndef TS_SEL
#define TS_SEL 0
#endif
#ifndef N_LAUNCH_MODE
#define N_LAUNCH_MODE 1
#endif

#define LAS __attribute__((address_space(3)))
typedef _Float16 h16;
typedef _Float16 h16x8 __attribute__((ext_vector_type(8)));
typedef _Float16 h16x4 __attribute__((ext_vector_type(4)));
typedef _Float16 h16x2 __attribute__((ext_vector_type(2)));
typedef short s16x8 __attribute__((ext_vector_type(8)));
typedef float f32x4 __attribute__((ext_vector_type(4)));
typedef float f32x2 __attribute__((ext_vector_type(2)));
typedef unsigned u32x4 __attribute__((ext_vector_type(4)));
typedef unsigned u32x2 __attribute__((ext_vector_type(2)));

constexpr int T = 8192, D = 2048, PW = 6144, FF = 5632, HW = 1024;
constexpr float ALPHA = 1.189207115002721f;
constexpr float LN_EPS = 1e-5f, RMS_EPS = 1e-6f;
constexpr size_t MiB = 1ull << 20;
constexpr size_t OFF_H0 = 0;
constexpr size_t OFF_WOUT = 32 * MiB;
constexpr size_t OFF_WIN = 40 * MiB;
constexpr size_t OFF_U = 64 * MiB;
constexpr size_t OFF_PQ = 160 * MiB;
constexpr size_t OFF_DEC = 240 * MiB;
constexpr size_t OFF_TAB = 241 * MiB;
constexpr size_t OFF_ODIR = 40 * MiB;
constexpr size_t OFF_MIX = 104 * MiB;
constexpr size_t OFF_WD = 204 * MiB;
constexpr size_t OFF_ACT = 40 * MiB;
constexpr size_t OFF_CUMB = 242 * MiB;
constexpr size_t OFF_SFIN = 243 * MiB;
constexpr size_t OFF_XB5 = 243 * MiB + 512 * 1024;
constexpr size_t OFF_XB8 = 240 * MiB;
constexpr size_t OFF_CNT = 241 * MiB + 900 * 1024;
constexpr size_t OFF_BAR = 241 * MiB + 920 * 1024;
constexpr size_t WS_NEED = 244 * MiB;
constexpr size_t UBLK = (size_t)T * 1024;
constexpr int REC_BYTES = 40960;
constexpr int LDS_BYTES = 131072 + 16;

struct Params {
    const float *x, *ln_emb_g, *ln_emb_b, *w_in, *lbf, *lbb, *g_norm, *w_out, *ln1_g, *ln1_b, *w_gate, *w_up, *w_down, *ln2_g, *ln2_b;
    float* out; unsigned char* ws; int ph_lo, ph_hi;
};

__device__ __forceinline__ float wave_sum(float v) {
#pragma unroll
    for (int o = 1; o < 64; o <<= 1) v += __shfl_xor(v, o);
    return v;
}
__device__ __forceinline__ float silu_f(float x) { return x * __builtin_amdgcn_rcpf(1.0f + __expf(-x)); }
__device__ __forceinline__ unsigned short f2bf(float f) { unsigned u = __float_as_uint(f); u += 0x7FFFu + ((u >> 16) & 1u); return (unsigned short)(u >> 16); }
__device__ __forceinline__ unsigned pkh(float a, float b) { h16x2 v; v.x = (h16)a; v.y = (h16)b; return __builtin_bit_cast(unsigned, v); }
#ifndef GEMM_BF16
#define GEMM_BF16 1
#endif
typedef __bf16 bf16x8_t __attribute__((ext_vector_type(8)));
__device__ __forceinline__ unsigned pko(float a, float b) {
#if GEMM_BF16
    typedef __bf16 bf16x2_t __attribute__((ext_vector_type(2))); bf16x2_t v; v.x = (__bf16)a; v.y = (__bf16)b; return __builtin_bit_cast(unsigned, v);
#else
    return pkh(a, b);
#endif
}
__device__ __forceinline__ float opf(h16 raw) {
#if GEMM_BF16
    return __uint_as_float((unsigned)__builtin_bit_cast(unsigned short, raw) << 16);
#else
    return (float)raw;
#endif
}
#define LDS_WAIT() asm volatile("s_waitcnt lgkmcnt(0)" ::: "memory")
#define LBAR() do { asm volatile("s_waitcnt lgkmcnt(0)" ::: "memory"); __builtin_amdgcn_s_barrier(); asm volatile("" ::: "memory"); } while (0)

namespace pg8 {
constexpr int BM = 256, BK = 64, HALF = 128, HTB = HALF * BK * 2, STAGE_BYTES = 8 * HTB, NXCD = 8, WGM = 8;
__device__ __forceinline__ int lds_byte(int r, int c) { const int st = (r >> 4) * 2 + (c >> 5), rr = r & 15, cc = c & 31, ob = rr * 64 + cc * 2; return st * 1024 + (ob ^ (((ob >> 9) & 1) << 5)); }
__device__ __forceinline__ void stage_rc(int b, int& R, int& C) { const int st = b / 1024, sb = b % 1024, swz = sb ^ (((sb >> 9) & 1) << 5); R = (st >> 1) * 16 + swz / 64; C = (st & 1) * 32 + (swz % 64) / 2; }
__device__ __forceinline__ int perm32(int rho) { const int n = rho >> 4, i = rho & 15; return 8 * (i >> 2) + 4 * n + (i & 3); }
struct Unit { int pm, pn; };
struct Gemm { const h16* A; const h16* Bt; int M, N, K; };
struct StaticOrder {
    int nM, nN, nwg, G, c;
    __device__ void init(int M, int N, int G_, int c_) { nM = M / BM; nN = N / BM; nwg = nM * nN; G = G_; c = c_; }
    __device__ bool next(int i, Unit& u) const {
        const long L = (long)i * G + c; if (L >= nwg) return false;
        int wgid = (int)L; { const int q = nwg / NXCD, r = nwg % NXCD, xcd = wgid % NXCD, off = wgid / NXCD; wgid = (xcd < r ? xcd * (q + 1) : r * (q + 1) + (xcd - r) * q) + off; }
        const int nig = WGM * nN, gid = wgid / nig, fm = gid * WGM, gsz = (nM - fm) < WGM ? (nM - fm) : WGM;
        u.pm = fm + ((wgid % nig) % gsz); u.pn = (wgid % nig) / gsz; return true;
    }
};

template <class Epi>
__device__ __forceinline__ void gemm_phase(LAS unsigned char* lds, const Gemm g, const StaticOrder& S, const Epi& E) {
    const int tid = threadIdx.x, wid = __builtin_amdgcn_readfirstlane(tid >> 6), lane = tid & 63, wr = wid >> 2, wc = wid & 3, fr = lane & 15, fq = lane >> 4;
    const int K = g.K, nt = K / BK;
    unsigned voffA[2], voffB[2];
#pragma unroll
    for (int i = 0; i < 2; ++i) { int R, C; stage_rc(tid * 16 + i * 8192, R, C); const int Rb = Epi::PERM ? ((R & ~31) + perm32(R & 31)) : R;
        voffA[i] = (unsigned)(R * K + C) * 2u; voffB[i] = (unsigned)(Rb * K + C) * 2u; }
    const size_t kstep = (size_t)(BK * 2);
    const size_t hstep = (size_t)HALF * K * 2;
    const size_t tstep = 2 * hstep;
    const unsigned ldsw = (unsigned)wid * 1024u;
    const int aoff = lds_byte(wr * 64 + fr, fq * 8), boff = lds_byte(wc * 32 + fr, fq * 8);
#define PG8_SA(b, h) (((b) * 2 + (h)) * HTB)
#define PG8_SB(b, h) ((4 + (b) * 2 + (h)) * HTB)
#define PG8_STAGE(bufoff, gbase, voff) do { _Pragma("unroll") for (int _i = 0; _i < 2; ++_i) \
        __builtin_amdgcn_global_load_lds((const unsigned*)((const char*)(gbase) + (voff)[_i]), (LAS unsigned*)(lds + (bufoff) + ldsw + _i * 8192), 16, 0, 0); } while (0)
#define PG8_LDA(dst, b, h) do { _Pragma("unroll") for (int m = 0; m < 4; ++m) _Pragma("unroll") for (int k = 0; k < 2; ++k) dst[m][k] = *(const LAS h16x8*)(lds + PG8_SA(b, h) + aoff + m * 2048 + k * 1024); } while (0)
#define PG8_LDB(dst, b, h) do { _Pragma("unroll") for (int n = 0; n < 2; ++n) _Pragma("unroll") for (int k = 0; k < 2; ++k) dst[n][k] = *(const LAS h16x8*)(lds + PG8_SB(b, h) + boff + n * 2048 + k * 1024); } while (0)
#define PG8_MMA(ai, bj, At, Bt) do { __builtin_amdgcn_s_setprio(1); _Pragma("unroll") for (int m = 0; m < 4; ++m) _Pragma("unroll") for (int n = 0; n < 2; ++n) _Pragma("unroll") for (int k = 0; k < 2; ++k) \
        acc[ai][bj][m][n] = GEMM_BF16 ? __builtin_amdgcn_mfma_f32_16x16x32_bf16(__builtin_bit_cast(bf16x8_t, Bt[n][k]), __builtin_bit_cast(bf16x8_t, At[m][k]), acc[ai][bj][m][n], 0, 0, 0) : __builtin_amdgcn_mfma_f32_16x16x32_f16(Bt[n][k], At[m][k], acc[ai][bj][m][n], 0, 0, 0); __builtin_amdgcn_s_setprio(0); } while (0)
#define PG8_WAIT_V(n) asm volatile("s_waitcnt vmcnt(" #n ")" ::: "memory")
#define PG8_WAIT_L(n) asm volatile("s_waitcnt lgkmcnt(" #n ")" ::: "memory")
#define PG8_BAR __builtin_amdgcn_s_barrier()
#define PG8_SCHED __builtin_amdgcn_sched_barrier(0)
    Unit cur, nxt; int ui = 0;
    if (!S.next(0, cur)) return;
    f32x4 acc[2][2][4][2];
#pragma unroll
    for (int a = 0; a < 2; ++a)
#pragma unroll
        for (int b = 0; b < 2; ++b)
#pragma unroll
            for (int m = 0; m < 4; ++m)
#pragma unroll
                for (int n = 0; n < 2; ++n) acc[a][b][m][n] = (f32x4){0.f, 0.f, 0.f, 0.f};
    h16x8 At[4][2], B0[2][2], B1[2][2];
    const char* cA = (const char*)g.A + (size_t)cur.pm * tstep; const char* cB = (const char*)g.Bt + (size_t)cur.pn * tstep;
    PG8_STAGE(PG8_SB(0, 0), cB, voffB); PG8_STAGE(PG8_SB(0, 1), cB + hstep, voffB); PG8_STAGE(PG8_SA(0, 0), cA, voffA); PG8_STAGE(PG8_SA(0, 1), cA + hstep, voffA);
    if (wr == 1) PG8_BAR;
    PG8_WAIT_V(2); PG8_BAR;
    PG8_STAGE(PG8_SB(1, 0), cB + kstep, voffB); PG8_STAGE(PG8_SA(1, 0), cA + kstep, voffA); PG8_STAGE(PG8_SB(1, 1), cB + hstep + kstep, voffB);
    PG8_WAIT_V(6); PG8_BAR;
    for (;;) {
        const bool has_next = S.next(ui + 1, nxt);
        const char* nA = has_next ? (const char*)g.A + (size_t)nxt.pm * tstep : cA; const char* nB = has_next ? (const char*)g.Bt + (size_t)nxt.pn * tstep : cB;
        for (int t = 0; t < nt; t += 2) {
            const bool last = (t == nt - 2);
            const char* a1 = cA + (size_t)(t + 1) * kstep;
            const char* a2 = last ? nA : cA + (size_t)(t + 2) * kstep; const char* b2 = last ? nB : cB + (size_t)(t + 2) * kstep;
            const char* a3 = a2 + kstep; const char* b3 = b2 + kstep;
            PG8_LDB(B0, 0, 0); PG8_LDB(B1, 0, 1); PG8_SCHED; PG8_LDA(At, 0, 0); PG8_STAGE(PG8_SA(1, 1), a1 + hstep, voffA);
            PG8_WAIT_V(8); PG8_WAIT_L(0); PG8_BAR; PG8_MMA(0, 0, At, B0); PG8_MMA(0, 1, At, B1); PG8_BAR; PG8_SCHED;
            PG8_LDA(At, 0, 1); PG8_STAGE(PG8_SB(0, 0), b2, voffB); PG8_STAGE(PG8_SB(0, 1), b2 + hstep, voffB); PG8_STAGE(PG8_SA(0, 0), a2, voffA);
            PG8_WAIT_V(8); PG8_WAIT_L(0); PG8_BAR; PG8_MMA(1, 0, At, B0); PG8_MMA(1, 1, At, B1); PG8_BAR; PG8_SCHED;
            PG8_LDB(B0, 1, 0); PG8_LDB(B1, 1, 1); PG8_SCHED; PG8_LDA(At, 1, 0); PG8_STAGE(PG8_SA(0, 1), a2 + hstep, voffA);
            PG8_WAIT_V(8); PG8_WAIT_L(0); PG8_BAR; PG8_MMA(0, 0, At, B0); PG8_MMA(0, 1, At, B1); PG8_BAR; PG8_SCHED;
            PG8_LDA(At, 1, 1); PG8_STAGE(PG8_SB(1, 0), b3, voffB); PG8_STAGE(PG8_SB(1, 1), b3 + hstep, voffB); PG8_STAGE(PG8_SA(1, 0), a3, voffA);
            PG8_WAIT_V(8); PG8_WAIT_L(0); PG8_BAR; PG8_MMA(1, 0, At, B0); PG8_MMA(1, 1, At, B1); PG8_BAR; PG8_SCHED;
        }
        if (wr == 0) PG8_BAR;
        if constexpr (!Epi::AFTER_DRAIN) E(acc, cur, wr, wc, fr, fq);
        if (!has_next) break;
#pragma unroll
        for (int a = 0; a < 2; ++a)
#pragma unroll
            for (int b = 0; b < 2; ++b)
#pragma unroll
                for (int m = 0; m < 4; ++m)
#pragma unroll
                    for (int n = 0; n < 2; ++n) acc[a][b][m][n] = (f32x4){0.f, 0.f, 0.f, 0.f};
        cur = nxt; cA = nA; cB = nB; ++ui;
        if (wr == 1) PG8_BAR;
    }
    PG8_WAIT_V(0);
    PG8_BAR;
    if constexpr (Epi::AFTER_DRAIN) E.fused(acc, cur, wr, wc, fr, fq, lds, wid, lane);
#undef PG8_SA
#undef PG8_SB
#undef PG8_STAGE
#undef PG8_LDA
#undef PG8_LDB
#undef PG8_MMA
#undef PG8_WAIT_V
#undef PG8_WAIT_L
#undef PG8_BAR
#undef PG8_SCHED
}

struct EpiU {
    static constexpr bool PERM = true, AFTER_DRAIN = false;
    h16* ubase;
    __device__ __forceinline__ void operator()(const f32x4 (&acc)[2][2][4][2], const Unit& u, int wr, int wc, int fr, int fq) const {
        const int row0 = u.pm * BM + wr * 64 + fr; int colt = u.pn * BM; const int blk = colt >> 10; colt &= 1023;
        const int dblk = blk == 4 ? 5 : (blk == 5 ? 4 : blk);
        h16* base = ubase + (size_t)dblk * UBLK; const bool act = (blk == 0) || (blk == 4);
        const int col0 = colt + wc * 32 + 8 * fq;
#pragma unroll
        for (int ai = 0; ai < 2; ++ai)
#pragma unroll
            for (int m = 0; m < 4; ++m) { h16* rowp = base + (size_t)(row0 + ai * HALF + m * 16) * 1024 + col0;
#pragma unroll
                for (int bj = 0; bj < 2; ++bj) { f32x4 v0 = acc[ai][bj][m][0], v1 = acc[ai][bj][m][1];
                    if (act) {
#pragma unroll
                        for (int j = 0; j < 4; ++j) { v0[j] = silu_f(v0[j]); v1[j] = silu_f(v1[j]); } }
                    u32x4 w; w.x = pkh(v0[0], v0[1]); w.y = pkh(v0[2], v0[3]); w.z = pkh(v1[0], v1[1]); w.w = pkh(v1[2], v1[3]);
                    *(u32x4*)(rowp + bj * HALF) = w; } }
    }
};
template <bool FINAL> struct EpiLn {
    static constexpr bool PERM = false, AFTER_DRAIN = true;
    const h16* H; void* O; const float* gam; const float* bet; float* xbuf; unsigned* cnt;
    __device__ __forceinline__ void operator()(const f32x4 (&)[2][2][4][2], const Unit&, int, int, int, int) const {}
    __device__ __forceinline__ void fused(const f32x4 (&acc)[2][2][4][2], const Unit& u, int wr, int wc, int fr, int fq, LAS unsigned char* lds, int wid, int lane) const {
        const int row0 = u.pm * BM + wr * 64 + fr, col0 = u.pn * BM + wc * 32 + 4 * fq, tid = wid * 64 + lane;
        f32x4 y[2][2][4][2];
#pragma unroll
        for (int ai = 0; ai < 2; ++ai) {
            h16x4 hv[4][2][2];
#pragma unroll
            for (int m = 0; m < 4; ++m)
#pragma unroll
                for (int bj = 0; bj < 2; ++bj)
#pragma unroll
                    for (int n = 0; n < 2; ++n) hv[m][bj][n] = *(const h16x4*)(H + (size_t)(row0 + ai * HALF + m * 16) * D + col0 + bj * HALF + n * 16);
#pragma unroll
            for (int m = 0; m < 4; ++m)
#pragma unroll
                for (int bj = 0; bj < 2; ++bj)
#pragma unroll
                    for (int n = 0; n < 2; ++n) { f32x4 v = acc[ai][bj][m][n]; const h16x4 h4 = hv[m][bj][n];
                        v[0] += ALPHA * opf(h4[0]); v[1] += ALPHA * opf(h4[1]); v[2] += ALPHA * opf(h4[2]); v[3] += ALPHA * opf(h4[3]); y[ai][bj][m][n] = v; }
        }
        LAS f32x2* P = (LAS f32x2*)lds;
        LAS f32x2* Sm = (LAS f32x2*)(lds + 8192);
#pragma unroll
        for (int ai = 0; ai < 2; ++ai)
#pragma unroll
            for (int m = 0; m < 4; ++m) { float s1 = 0.f, s2 = 0.f;
#pragma unroll
                for (int bj = 0; bj < 2; ++bj)
#pragma unroll
                    for (int n = 0; n < 2; ++n) { const f32x4 v = y[ai][bj][m][n]; s1 += (v[0] + v[1]) + (v[2] + v[3]); s2 += (v[0] * v[0] + v[1] * v[1]) + (v[2] * v[2] + v[3] * v[3]); }
                s1 += __shfl_xor(s1, 16); s1 += __shfl_xor(s1, 32); s2 += __shfl_xor(s2, 16); s2 += __shfl_xor(s2, 32);
                if (fq == 0) P[(ai * HALF + wr * 64 + m * 16 + fr) * 4 + wc] = (f32x2){s1, s2}; }
        __syncthreads();
        if (tid < 256) { const f32x2 a = P[tid * 4 + 0], b = P[tid * 4 + 1], c = P[tid * 4 + 2], d = P[tid * 4 + 3];
            float* xp = xbuf + ((size_t)(u.pm * 256 + tid) * 8 + u.pn) * 2;
            __hip_atomic_store(xp, (a.x + b.x) + (c.x + d.x), __ATOMIC_RELAXED, __HIP_MEMORY_SCOPE_AGENT);
            __hip_atomic_store(xp + 1, (a.y + b.y) + (c.y + d.y), __ATOMIC_RELAXED, __HIP_MEMORY_SCOPE_AGENT); }
        asm volatile("s_waitcnt vmcnt(0)" ::: "memory");
        __syncthreads();
        if (tid == 0) {
            unsigned* c = cnt + 64 * u.pm;
            __hip_atomic_fetch_add(c, 1u, __ATOMIC_RELAXED, __HIP_MEMORY_SCOPE_AGENT);
            unsigned spins = 0;
            while (__hip_atomic_load(c, __ATOMIC_RELAXED, __HIP_MEMORY_SCOPE_AGENT) < 8u && ++spins < (1u << 24)) __builtin_amdgcn_s_sleep(2);
        }
        __syncthreads();
        if (tid < 256) { float s1 = 0.f, s2 = 0.f; const float* xp = xbuf + (size_t)(u.pm * 256 + tid) * 16;
#pragma unroll
            for (int k = 0; k < 8; ++k) { s1 += __hip_atomic_load(xp + 2 * k, __ATOMIC_RELAXED, __HIP_MEMORY_SCOPE_AGENT); s2 += __hip_atomic_load(xp + 2 * k + 1, __ATOMIC_RELAXED, __HIP_MEMORY_SCOPE_AGENT); }
            const float mean = s1 * (1.f / D), var = s2 * (1.f / D) - mean * mean;
            Sm[tid] = (f32x2){mean, __builtin_amdgcn_rsqf(var + LN_EPS)}; }
        __syncthreads();
        f32x4 gg[2][2], bb[2][2];
        float dl = 0.f;
        if (FINAL && TS_SEL) { const unsigned long long* ts = (const unsigned long long*)((const unsigned char*)cnt - 2048 * 4 - 900 * 1024 + 600 * 1024); dl = (float)(ts[TS_SEL] - ts[0]) * 1e-6f; }
#pragma unroll
        for (int bj = 0; bj < 2; ++bj)
#pragma unroll
            for (int n = 0; n < 2; ++n) { gg[bj][n] = *(const f32x4*)(gam + col0 + bj * HALF + n * 16); bb[bj][n] = *(const f32x4*)(bet + col0 + bj * HALF + n * 16); }
        if (FINAL && TS_SEL && col0 == 0) bb[0][0][0] += dl;
#pragma unroll
        for (int ai = 0; ai < 2; ++ai)
#pragma unroll
            for (int m = 0; m < 4; ++m) { const f32x2 st = Sm[ai * HALF + wr * 64 + m * 16 + fr]; const size_t ro = (size_t)(row0 + ai * HALF + m * 16) * D + col0;
#pragma unroll
                for (int bj = 0; bj < 2; ++bj)
#pragma unroll
                    for (int n = 0; n < 2; ++n) { const f32x4 o = (y[ai][bj][m][n] - st.x) * st.y * gg[bj][n] + bb[bj][n];
                        if (FINAL) *(f32x4*)((float*)O + ro + bj * HALF + n * 16) = o;
                        else { u32x2 w2; w2.x = pko(o[0], o[1]); w2.y = pko(o[2], o[3]); *(u32x2*)((h16*)O + ro + bj * HALF + n * 16) = w2; } } }
    }
};
struct EpiGlu {
    static constexpr bool PERM = true, AFTER_DRAIN = false;
    h16* O;
    __device__ __forceinline__ void operator()(const f32x4 (&acc)[2][2][4][2], const Unit& u, int wr, int wc, int fr, int fq) const {
        const int row0 = u.pm * BM + wr * 64 + fr, col0 = u.pn * HALF + wc * 32 + 8 * fq;
#pragma unroll
        for (int ai = 0; ai < 2; ++ai)
#pragma unroll
            for (int m = 0; m < 4; ++m) { h16* rowp = O + (size_t)(row0 + ai * HALF + m * 16) * FF + col0;
                const f32x4 g0 = acc[ai][0][m][0], g1 = acc[ai][0][m][1], u0 = acc[ai][1][m][0], u1 = acc[ai][1][m][1];
                float r[8];
#pragma unroll
                for (int j = 0; j < 4; ++j) { r[j] = silu_f(g0[j]) * u0[j]; r[4 + j] = silu_f(g1[j]) * u1[j]; }
                u32x4 w; w.x = pko(r[0], r[1]); w.y = pko(r[2], r[3]); w.z = pko(r[4], r[5]); w.w = pko(r[6], r[7]);
                *(u32x4*)rowp = w; }
    }
};
}

template <class RM>
__device__ __forceinline__ void transpose_item(const float* W, int K, int N, h16* WT, LAS float* scr, int item, int lane, RM rm) {
    const int nblk = N / 32, kb = item / nblk, nb = item % nblk, k0 = 64 * kb, n0 = 32 * nb;
    f32x4 v[8];
#pragma unroll
    for (int i = 0; i < 8; ++i) v[i] = __builtin_nontemporal_load((const f32x4*)(W + (size_t)(k0 + (lane >> 3) + 8 * i) * N + n0 + 4 * (lane & 7)));
#pragma unroll
    for (int i = 0; i < 8; ++i) { LAS float* d = scr + ((lane >> 3) + 8 * i) * 33 + 4 * (lane & 7); d[0] = v[i][0]; d[1] = v[i][1]; d[2] = v[i][2]; d[3] = v[i][3]; }
    LDS_WAIT();
    const int c = lane & 7;
#pragma unroll
    for (int j = 0; j < 4; ++j) { const int n = (lane >> 3) + 8 * j; const LAS float* s = scr + (8 * c) * 33 + n;
        u32x4 o; o.x = pko(s[0 * 33], s[1 * 33]); o.y = pko(s[2 * 33], s[3 * 33]); o.z = pko(s[4 * 33], s[5 * 33]); o.w = pko(s[6 * 33], s[7 * 33]);
        *(u32x4*)(WT + (size_t)rm(n0 + n) * K + k0 + 8 * c) = o; }
    LDS_WAIT();
}
struct RmId { __device__ __forceinline__ int operator()(int n) const { return n; } };
struct RmGate { __device__ __forceinline__ int operator()(int n) const { return (n >> 7) * 256 + (n & 127); } };
struct RmUp { __device__ __forceinline__ int operator()(int n) const { return (n >> 7) * 256 + 128 + (n & 127); } };

struct LnAff { f32x4 g[8], b[8]; };
__device__ __forceinline__ void ln_load_aff(LnAff& A, const float* gam, const float* bet, int lane) {
#pragma unroll
    for (int j = 0; j < 8; ++j) { A.g[j] = *((const f32x4*)gam + 64 * j + lane); A.b[j] = *((const f32x4*)bet + 64 * j + lane); }
}
template <bool F32OUT>
__device__ __forceinline__ void ln_row(const float* xrow, const LnAff& A, void* orow, int lane) {
    const f32x4* xr = (const f32x4*)xrow + lane;
    f32x4 v[8]; float s = 0.f;
#pragma unroll
    for (int j = 0; j < 8; ++j) { v[j] = __builtin_nontemporal_load(xr + 64 * j); s += (v[j][0] + v[j][1]) + (v[j][2] + v[j][3]); }
    const float mean = wave_sum(s) * (1.f / D); float s2 = 0.f;
#pragma unroll
    for (int j = 0; j < 8; ++j) { v[j] = v[j] - mean; s2 += (v[j][0] * v[j][0] + v[j][1] * v[j][1]) + (v[j][2] * v[j][2] + v[j][3] * v[j][3]); }
    const float rstd = __builtin_amdgcn_rsqf(wave_sum(s2) * (1.f / D) + LN_EPS);
#pragma unroll
    for (int j = 0; j < 8; ++j) {
        f32x4 y = v[j] * rstd * A.g[j] + A.b[j];
        if (F32OUT) *((f32x4*)orow + 64 * j + lane) = y;
        else { u32x2 w; w.x = pko(y[0], y[1]); w.y = pko(y[2], y[3]); *((u32x2*)orow + 64 * j + lane) = w; }
    }
}

__device__ __forceinline__ void phase0(const Params& p, LAS unsigned char* lds) {
    const int tid = threadIdx.x, lane = tid & 63, wave = tid >> 6, G = gridDim.x;
    const int gw = blockIdx.x * 8 + wave, NGW = G * 8;
    h16* h0 = (h16*)(p.ws + OFF_H0);
    {
        h16* FcT = (h16*)(p.ws + OFF_TAB); h16* F128 = FcT + 512 * 256; h16* G64 = F128 + 256 * 256;
        const int gt = blockIdx.x * 512 + tid, NT = G * 512;
        for (int i = gt; i < 512 * 256; i += NT) { const int nn = i >> 8, c = i & 255, cp = nn >> 1, ri = nn & 1; const float fr = (float)((c * cp) & 255) * (1.f / 256.f);
            FcT[i] = (h16)((ri ? -__builtin_amdgcn_sinf(fr) : __builtin_amdgcn_cosf(fr)) * 0.0625f); }
        for (int i = gt; i < 256 * 256; i += NT) { const int rho = i >> 8, kap = i & 255, ka = rho >> 1, rp = rho & 1, ri = kap >> 7, th = kap & 127; const float fr = (float)((ka * th) & 127) * (1.f / 128.f);
            const float cs = __builtin_amdgcn_cosf(fr), sn = __builtin_amdgcn_sinf(fr); const float v = rp == 0 ? (ri == 0 ? cs : sn) : (ri == 0 ? -sn : cs);
            F128[i] = (h16)(v * 0.08838834764831845f); }
        for (int i = gt; i < 64 * 128; i += NT) { const int kb = i >> 7, kk = i & 127, ri = kk >> 6, tl = kk & 63; const float fr = (float)((kb * tl) & 63) * (1.f / 64.f);
            G64[i] = (h16)((ri ? __builtin_amdgcn_sinf(fr) : __builtin_amdgcn_cosf(fr)) * 0.125f); }
    }
    if (blockIdx.x == 0) { unsigned* c = (unsigned*)(p.ws + OFF_CNT); for (int i = tid; i < 4096 + 64; i += 512) c[i] = 0u; }
    { LnAff A; ln_load_aff(A, p.ln_emb_g, p.ln_emb_b, lane);
      for (int r = gw; r < T; r += NGW) ln_row<false>(p.x + (size_t)r * D, A, h0 + (size_t)r * D, lane); }
    LAS float* scr = (LAS float*)(lds + wave * 8448);
    constexpr int I_IN = (D / 64) * (PW / 32), I_OUT = (D / 64) * (D / 32);
    for (int it = gw; it < I_IN + I_OUT; it += NGW) {
        if (it < I_IN) transpose_item(p.w_in, D, PW, (h16*)(p.ws + OFF_WIN), scr, it, lane, RmId());
        else transpose_item(p.w_out, D, D, (h16*)(p.ws + OFF_WOUT), scr, it - I_IN, lane, RmId());
    }
}

__device__ __forceinline__ void fa_tile(const Params& p, LAS unsigned char* lds, int tile) {
    const int tid = threadIdx.x, lane = tid & 63, w = __builtin_amdgcn_readfirstlane(tid >> 6), r = lane & 15, g = lane >> 4;
    const int t_lo = tile & 63, grp = tile >> 6;
    const h16* U = (const h16*)(p.ws + OFF_U) + 4 * UBLK;
    const h16* FcT = (const h16*)(p.ws + OFF_TAB); const h16* F128 = FcT + 512 * 256;
    h16* Wtw = (h16*)p.out;
    LAS unsigned char* ldsZ = lds + 67584;
#pragma unroll
    for (int i = 0; i < 8; ++i) { const int idx = tid + 512 * i, row = idx >> 5, ch = idx & 31;
        const u32x4 v = *(const u32x4*)(U + (size_t)(t_lo + 64 * row) * 1024 + grp * 256 + ch * 8);
        *(LAS u32x4*)(lds + row * 528 + ch * 16) = v; }
    h16x8 FA3[2][8];
#pragma unroll
    for (int mi = 0; mi < 2; ++mi)
#pragma unroll
        for (int ks = 0; ks < 8; ++ks) FA3[mi][ks] = *(const h16x8*)(F128 + (16 * (2 * w + mi) + r) * 256 + 32 * ks + 8 * g);
    LBAR();
    for (int cb = 0; cb < 4; ++cb) {
        {
            h16x8 Bf[8];
#pragma unroll
            for (int ks = 0; ks < 8; ++ks) Bf[ks] = *(const h16x8*)(FcT + (cb * 128 + 16 * w + r) * 256 + 32 * ks + 8 * g);
            f32x4 acc[8];
#pragma unroll
            for (int mt = 0; mt < 8; ++mt) acc[mt] = (f32x4){0.f, 0.f, 0.f, 0.f};
#pragma unroll
            for (int mt = 0; mt < 8; ++mt)
#pragma unroll
                for (int ks = 0; ks < 8; ++ks) { const h16x8 a = *(const LAS h16x8*)(lds + (16 * mt + r) * 528 + (32 * ks + 8 * g) * 2);
                    acc[mt] = __builtin_amdgcn_mfma_f32_16x16x32_f16(a, Bf[ks], acc[mt], 0, 0, 0); }
            const int n_l = 16 * w + r, zrow = (n_l >> 1) * 264 + (n_l & 1) * 128;
#pragma unroll
            for (int mt = 0; mt < 8; ++mt) { u32x2 o; o.x = pkh(acc[mt][0], acc[mt][1]); o.y = pkh(acc[mt][2], acc[mt][3]);
                *(LAS u32x2*)(ldsZ + (zrow + 16 * mt + 4 * g) * 2) = o; }
        }
        LBAR();
        {
            f32x4 acc3[2][4];
#pragma unroll
            for (int mi = 0; mi < 2; ++mi)
#pragma unroll
                for (int nt = 0; nt < 4; ++nt) acc3[mi][nt] = (f32x4){0.f, 0.f, 0.f, 0.f};
#pragma unroll
            for (int ks = 0; ks < 8; ++ks)
#pragma unroll
                for (int nt = 0; nt < 4; ++nt) { const h16x8 b = *(const LAS h16x8*)(ldsZ + ((16 * nt + r) * 264 + 32 * ks + 8 * g) * 2);
#pragma unroll
                    for (int mi = 0; mi < 2; ++mi) acc3[mi][nt] = __builtin_amdgcn_mfma_f32_16x16x32_f16(FA3[mi][ks], b, acc3[mi][nt], 0, 0, 0); }
#pragma unroll
            for (int mi = 0; mi < 2; ++mi)
#pragma unroll
                for (int pp = 0; pp < 2; ++pp) { const int k_a = 8 * (2 * w + mi) + 2 * g + pp; const float ang = (float)(t_lo * k_a) * (1.f / 8192.f);
                    const float wr_ = __builtin_amdgcn_cosf(ang), wi_ = -__builtin_amdgcn_sinf(ang);
                    h16* dst = Wtw + ((((size_t)t_lo * 128 + k_a) * 4 + grp) * 256 + cb * 64 + r) * 2;
#pragma unroll
                    for (int nt = 0; nt < 4; ++nt) { const float re = acc3[mi][nt][2 * pp], im = acc3[mi][nt][2 * pp + 1];
                        *(unsigned*)(dst + nt * 32) = pkh(re * wr_ - im * wi_, re * wi_ + im * wr_); } }
        }
        LBAR();
    }
}

__device__ __forceinline__ void fb_tile(const Params& p, LAS unsigned char* lds, int tile, const h16x8 (&Bg)[4][4]) {
    const int tid = threadIdx.x, lane = tid & 63, w = __builtin_amdgcn_readfirstlane(tid >> 6), r = lane & 15, g = lane >> 4;
    const int k_a = tile & 127, grp = tile >> 7;
    const h16* Wtw = (const h16*)p.out;
    h16* mix = (h16*)(p.ws + OFF_MIX);
    LAS h16* ldsW = (LAS h16*)lds;
#pragma unroll
    for (int i = 0; i < 8; ++i) { const int mm = w * 8 + i, t_lo = 16 * (mm & 3) + (tid & 15), ch = 4 * (mm >> 2) + ((tid >> 4) & 3);
        const h16x8 v = *(const h16x8*)(Wtw + ((((size_t)t_lo * 128 + k_a) * 4 + grp) * 256 + 4 * ch) * 2);
#pragma unroll
        for (int q = 0; q < 4; ++q) { ldsW[(4 * ch + q) * 136 + t_lo] = v[2 * q]; ldsW[(4 * ch + q) * 136 + 64 + t_lo] = v[2 * q + 1]; } }
    LBAR();
    f32x4 acc[2][4];
#pragma unroll
    for (int mi = 0; mi < 2; ++mi)
#pragma unroll
        for (int nt = 0; nt < 4; ++nt) acc[mi][nt] = (f32x4){0.f, 0.f, 0.f, 0.f};
#pragma unroll
    for (int ks = 0; ks < 4; ++ks)
#pragma unroll
        for (int mi = 0; mi < 2; ++mi) { const h16x8 a = *(const LAS h16x8*)(ldsW + (16 * (2 * w + mi) + r) * 136 + 32 * ks + 8 * g);
#pragma unroll
            for (int nt = 0; nt < 4; ++nt) acc[mi][nt] = __builtin_amdgcn_mfma_f32_16x16x32_f16(a, Bg[nt][ks], acc[mi][nt], 0, 0, 0); }
#pragma unroll
    for (int mi = 0; mi < 2; ++mi)
#pragma unroll
        for (int nt = 0; nt < 4; ++nt) { const int tp = k_a + 128 * (16 * nt + r); u32x2 o; o.x = pko(acc[mi][nt][0], acc[mi][nt][1]); o.y = pko(acc[mi][nt][2], acc[mi][nt][3]);
            *(u32x2*)(mix + (size_t)tp * D + 1024 + grp * 256 + 16 * (2 * w + mi) + 4 * g) = o; }
    LBAR();
}

__device__ __forceinline__ void prep_item(const Params& p, LAS unsigned char* lds, int item) {
    const int tid = threadIdx.x, lane = tid & 63, w = __builtin_amdgcn_readfirstlane(tid >> 6), r = lane & 15, g = lane >> 4;
    const int n = item & 127, h = (item >> 7) & 7, d = item >> 10;
    const h16* ub = (const h16*)(p.ws + OFF_U);
    const h16* uq = ub, *uv = ub + UBLK, *uz = ub + (size_t)(2 + d) * UBLK;
    unsigned char* rec = p.ws + OFF_PQ + (size_t)item * REC_BYTES;
    h16* vfr = (h16*)((unsigned char*)p.out + 32 * MiB + (size_t)item * 16384);
    float* dec = (float*)(p.ws + OFF_DEC) + (size_t)item * 128;
    LAS unsigned short* Qb = (LAS unsigned short*)lds;
    LAS unsigned short* KIb = (LAS unsigned short*)(lds + 17408);
    LAS h16* Qh = (LAS h16*)(lds + 34816);
    LAS float* segtot = (LAS float*)(lds + 52224);
    LAS h16* KEt = (LAS h16*)(lds + 60416);
    LAS h16* Vt = (LAS h16*)(lds + 78848);
    const int kq = tid & 31, seg = tid >> 5, ch = h * 128 + 4 * kq;
    const float* lbl = d ? p.lbb : p.lbf;
    f32x4 lb;
    { const f32x4 l0 = *(const f32x4*)(lbl + ch), l1 = *(const f32x4*)(lbl + 1024 + ch);
#pragma unroll
      for (int c = 0; c < 4; ++c) lb[c] = __builtin_amdgcn_rcpf(1.0f + __expf(l1[c] - l0[c])); }
    h16x4 zr[4], qr[4], vr[4];
#pragma unroll
    for (int jj = 0; jj < 4; ++jj) { const int tau = 64 * n + 4 * seg + jj, t = d ? (T - 1 - tau) : tau; const size_t o = (size_t)t * 1024 + ch;
        zr[jj] = *(const h16x4*)(uz + o); qr[jj] = *(const h16x4*)(uq + o); vr[jj] = *(const h16x4*)(uv + o); }
    f32x4 bc[4], kk[4], run = (f32x4){0.f, 0.f, 0.f, 0.f};
#pragma unroll
    for (int jj = 0; jj < 4; ++jj)
#pragma unroll
        for (int c = 0; c < 4; ++c) { const float z = (float)zr[jj][c];
            const float sg = __builtin_amdgcn_rcpf(1.0f + __expf(-z));
            const float f = lb[c] + (1.0f - lb[c]) * sg;
            run[c] += __logf(f); bc[jj][c] = run[c]; kk[jj][c] = 1.0f - f; }
    *(LAS f32x4*)(segtot + seg * 128 + 4 * kq) = run;
    LBAR();
    f32x4 pre = (f32x4){0.f, 0.f, 0.f, 0.f}, tot = (f32x4){0.f, 0.f, 0.f, 0.f};
#pragma unroll
    for (int sI = 0; sI < 16; ++sI) { const f32x4 v = *(const LAS f32x4*)(segtot + sI * 128 + 4 * kq); tot += v; if (sI < seg) pre += v; }
    if (seg == 0) *(f32x4*)(dec + 4 * kq) = tot;
    {
        float kef[4][4];
#pragma unroll
        for (int jj = 0; jj < 4; ++jj) { const int j = 4 * seg + jj; float qd[4], ki[4];
#pragma unroll
            for (int c = 0; c < 4; ++c) { const float b = pre[c] + bc[jj][c];
                qd[c] = (float)qr[jj][c] * __expf(b); ki[c] = kk[jj][c] * __expf(-b); kef[c][jj] = kk[jj][c] * __expf(tot[c] - b); }
            u32x2 qb2, kb2, qh2;
            qb2.x = (unsigned)f2bf(qd[0]) | ((unsigned)f2bf(qd[1]) << 16); qb2.y = (unsigned)f2bf(qd[2]) | ((unsigned)f2bf(qd[3]) << 16);
            kb2.x = (unsigned)f2bf(ki[0]) | ((unsigned)f2bf(ki[1]) << 16); kb2.y = (unsigned)f2bf(ki[2]) | ((unsigned)f2bf(ki[3]) << 16);
            qh2.x = pkh(qd[0], qd[1]); qh2.y = pkh(qd[2], qd[3]);
            *(LAS u32x2*)(Qb + j * 136 + 4 * kq) = qb2; *(LAS u32x2*)(KIb + j * 136 + 4 * kq) = kb2; *(LAS u32x2*)(Qh + j * 136 + 4 * kq) = qh2; }
#pragma unroll
        for (int c = 0; c < 4; ++c) { u32x2 ke2; ke2.x = pkh(kef[c][0], kef[c][1]); ke2.y = pkh(kef[c][2], kef[c][3]);
            h16x4 v4; v4[0] = vr[0][c]; v4[1] = vr[1][c]; v4[2] = vr[2][c]; v4[3] = vr[3][c];
            *(LAS u32x2*)(KEt + (4 * kq + c) * 72 + 4 * seg) = ke2;
            *(LAS u32x2*)(Vt + (4 * kq + c) * 72 + 4 * seg) = __builtin_bit_cast(u32x2, v4); }
    }
    LBAR();
#pragma unroll
    for (int i = 0; i < 2; ++i) { const int sl = tid + 512 * i, lp = sl & 63, blk = sl >> 6, kk2 = 16 * (blk >> 1) + (lp & 15), s0 = 32 * (blk & 1) + 8 * (lp >> 4);
        *(u32x4*)(rec + 24576 + (size_t)sl * 16) = *(const LAS u32x4*)(KEt + kk2 * 72 + s0);
        *(u32x4*)((unsigned char*)vfr + (size_t)sl * 16) = *(const LAS u32x4*)(Vt + kk2 * 72 + s0); }
#pragma unroll
    for (int i = 0; i < 2; ++i) { const int sl = tid + 512 * i, lp = sl & 63, jp = (sl >> 6) & 1, wq = sl >> 7, rr = lp & 15, gg = lp >> 4;
        u32x4 v; const u32x2 v0 = *(const LAS u32x2*)(Qh + (32 * jp + rr) * 136 + 16 * wq + 4 * gg), v1 = *(const LAS u32x2*)(Qh + (32 * jp + 16 + rr) * 136 + 16 * wq + 4 * gg);
        v.x = v0.x; v.y = v0.y; v.z = v1.x; v.w = v1.y;
        *(u32x4*)(rec + 8192 + (size_t)sl * 16) = v;
    }
    {
        const int jt = w >> 1;
#pragma unroll
        for (int si = 0; si < 2; ++si) { const int st = 2 * (w & 1) + si;
            f32x4 a4 = (f32x4){0.f, 0.f, 0.f, 0.f};
            if (st <= jt) {
#pragma unroll
                for (int ks = 0; ks < 4; ++ks) { const s16x8 a = *(const LAS s16x8*)(KIb + (16 * st + r) * 136 + 32 * ks + 8 * g); const s16x8 b = *(const LAS s16x8*)(Qb + (16 * jt + r) * 136 + 32 * ks + 8 * g);
                    a4 = __builtin_amdgcn_mfma_f32_16x16x32_bf16(__builtin_bit_cast(__bf16 __attribute__((ext_vector_type(8))), a), __builtin_bit_cast(__bf16 __attribute__((ext_vector_type(8))), b), a4, 0, 0, 0); }
            }
            const int j = 16 * jt + r;
#pragma unroll
            for (int i = 0; i < 4; ++i) { const int s = 16 * st + 4 * g + i; if (s > j) a4[i] = 0.f; }
            u32x2 o; o.x = pkh(a4[0], a4[1]); o.y = pkh(a4[2], a4[3]);
            const int lp = (2 * (st & 1) + (g >> 1)) * 16 + r;
            *(u32x2*)(rec + ((size_t)(jt * 2 + (st >> 1)) * 64 + lp) * 16 + 8 * (g & 1)) = o; }
    }
    LBAR();
}

struct StepLd { h16x8 ke0, ke1, bv0, bv1, pf, q01, q23; f32x4 dec; };
__device__ __forceinline__ void scan_load(StepLd& L, const unsigned char* rec0, const unsigned char* vf0, const float* dec0, int n, int w, int lane, int vs) {
    n = n < 127 ? n : 127;
    const unsigned char* rec = rec0 + (size_t)n * REC_BYTES;
    L.pf = *(const h16x8*)(rec + ((size_t)((w & 3) * 2 + (w >> 2)) * 64 + lane) * 16);
    L.q01 = *(const h16x8*)(rec + 8192 + ((size_t)(w * 2 + 0) * 64 + lane) * 16);
    L.q23 = *(const h16x8*)(rec + 8192 + ((size_t)(w * 2 + 1) * 64 + lane) * 16);
    L.ke0 = *(const h16x8*)(rec + 24576 + ((size_t)(w * 2 + 0) * 64 + lane) * 16);
    L.ke1 = *(const h16x8*)(rec + 24576 + ((size_t)(w * 2 + 1) * 64 + lane) * 16);
    if (w == 0) {
        const unsigned char* vf = vf0 + (size_t)n * 16384;
        L.bv0 = *(const h16x8*)(vf + ((size_t)(vs * 2 + 0) * 64 + lane) * 16);
        L.bv1 = *(const h16x8*)(vf + ((size_t)(vs * 2 + 1) * 64 + lane) * 16);
    }
    L.dec = *(const f32x4*)(dec0 + (size_t)n * 128 + 16 * w + 4 * (lane >> 4));
}
__device__ __forceinline__ void scan_step(const StepLd& L, const StepLd& Lnext, f32x4& S, f32x4& Bc, float* cumb, LAS unsigned char* lds, h16* od, int n, int d, int w, int lane, int vs) {
    const h16x4 sb = __builtin_convertvector(S, h16x4);
    f32x4 o[4];
    o[0] = __builtin_amdgcn_mfma_f32_16x16x16f16(sb, __builtin_shufflevector(L.q01, L.q01, 0, 1, 2, 3), (f32x4){0.f, 0.f, 0.f, 0.f}, 0, 0, 0);
    o[1] = __builtin_amdgcn_mfma_f32_16x16x16f16(sb, __builtin_shufflevector(L.q01, L.q01, 4, 5, 6, 7), (f32x4){0.f, 0.f, 0.f, 0.f}, 0, 0, 0);
    o[2] = __builtin_amdgcn_mfma_f32_16x16x16f16(sb, __builtin_shufflevector(L.q23, L.q23, 0, 1, 2, 3), (f32x4){0.f, 0.f, 0.f, 0.f}, 0, 0, 0);
    o[3] = __builtin_amdgcn_mfma_f32_16x16x16f16(sb, __builtin_shufflevector(L.q23, L.q23, 4, 5, 6, 7), (f32x4){0.f, 0.f, 0.f, 0.f}, 0, 0, 0);
    LAS unsigned char* vsl = lds + 65536 + (n & 1) * 2048;
    const h16x8 bv0 = *(const LAS h16x8*)(vsl + lane * 16), bv1 = *(const LAS h16x8*)(vsl + 1024 + lane * 16);
    const h16x8 bvp = (w >> 2) ? bv1 : bv0;
#pragma unroll
    for (int jt = 0; jt < 4; ++jt) if (jt == (w & 3)) o[jt] = __builtin_amdgcn_mfma_f32_16x16x32_f16(bvp, L.pf, o[jt], 0, 0, 0);
    if (vs == 0) *(f32x4*)(cumb + (size_t)n * 128 + 16 * w + 4 * (lane >> 4)) = Bc;
    Bc += L.dec;
    { f32x4 dk; dk[0] = __expf(L.dec[0]); dk[1] = __expf(L.dec[1]); dk[2] = __expf(L.dec[2]); dk[3] = __expf(L.dec[3]); S = S * dk; }
    S = __builtin_amdgcn_mfma_f32_16x16x32_f16(L.ke0, bv0, S, 0, 0, 0);
    S = __builtin_amdgcn_mfma_f32_16x16x32_f16(L.ke1, bv1, S, 0, 0, 0);
    if (w == 0) { LAS unsigned char* vn = lds + 65536 + ((n + 1) & 1) * 2048; *(LAS h16x8*)(vn + lane * 16) = Lnext.bv0; *(LAS h16x8*)(vn + 1024 + lane * 16) = Lnext.bv1; }
    LAS unsigned char* pb = lds + (n & 1) * 32768;
#pragma unroll
    for (int jt = 0; jt < 4; ++jt) *(LAS f32x4*)(pb + ((w * 4 + jt) * 64 + lane) * 16) = o[jt];
    asm volatile("s_waitcnt lgkmcnt(0)" ::: "memory"); __builtin_amdgcn_s_barrier(); asm volatile("" ::: "memory");
    if (w < 4) {
        f32x4 tot = (f32x4){0.f, 0.f, 0.f, 0.f};
#pragma unroll
        for (int ww = 0; ww < 8; ++ww) tot += *(const LAS f32x4*)(pb + ((ww * 4 + w) * 64 + lane) * 16);
        const int r = lane & 15, g = lane >> 4, tau = 64 * n + 16 * w + r, t = d ? (T - 1 - tau) : tau;
        *(h16x4*)(od + (size_t)t * 1024 + 4 * g) = __builtin_convertvector(tot, h16x4);
    }
}
__device__ __forceinline__ void scan_job(const Params& p, LAS unsigned char* lds, int job) {
    const int tid = threadIdx.x, lane = tid & 63, w = __builtin_amdgcn_readfirstlane(tid >> 6);
    const int idx = job >> 3, vs = idx & 7, pair = (job & 7) * 4 + (idx >> 3), hd = pair >> 1, sg = pair & 1, h = hd & 7, d = hd >> 3;
    const size_t item0 = (size_t)hd * 128;
    const unsigned char* rec0 = p.ws + OFF_PQ + item0 * REC_BYTES;
    const unsigned char* vf0 = (const unsigned char*)p.out + 32 * MiB + item0 * 16384;
    const float* dec0 = (const float*)(p.ws + OFF_DEC) + item0 * 128;
    float* cumb = (float*)(p.ws + OFF_CUMB) + item0 * 128;
    h16* od = (h16*)(p.ws + OFF_ODIR) + (size_t)d * T * 1024 + h * 128 + vs * 16;
    f32x4 S = (f32x4){0.f, 0.f, 0.f, 0.f}, Bc = (f32x4){0.f, 0.f, 0.f, 0.f};
    StepLd b0, b1, b2, b3;
    const int n0 = 64 * sg;
    scan_load(b0, rec0, vf0, dec0, n0, w, lane, vs); asm volatile("" ::: "memory"); scan_load(b1, rec0, vf0, dec0, n0 + 1, w, lane, vs); asm volatile("" ::: "memory"); scan_load(b2, rec0, vf0, dec0, n0 + 2, w, lane, vs); asm volatile("" ::: "memory");
    if (w == 0) { LAS unsigned char* vn = lds + 65536 + (n0 & 1) * 2048; *(LAS h16x8*)(vn + lane * 16) = b0.bv0; *(LAS h16x8*)(vn + 1024 + lane * 16) = b0.bv1; }
    LBAR();
    for (int n = n0; n < n0 + 64; n += 4) {
        scan_load(b3, rec0, vf0, dec0, n + 3, w, lane, vs); scan_step(b0, b1, S, Bc, cumb, lds, od, n, d, w, lane, vs);
        scan_load(b0, rec0, vf0, dec0, n + 4, w, lane, vs); scan_step(b1, b2, S, Bc, cumb, lds, od, n + 1, d, w, lane, vs);
        scan_load(b1, rec0, vf0, dec0, n + 5, w, lane, vs); scan_step(b2, b3, S, Bc, cumb, lds, od, n + 2, d, w, lane, vs);
        scan_load(b2, rec0, vf0, dec0, n + 6, w, lane, vs); scan_step(b3, b0, S, Bc, cumb, lds, od, n + 3, d, w, lane, vs);
    }
    if (sg == 0) *(h16x4*)(p.ws + OFF_SFIN + ((size_t)((hd * 8 + w) * 8 + vs) * 64 + lane) * 8) = __builtin_convertvector(S, h16x4);
    LBAR();
}

__device__ __forceinline__ void phase4(const Params& p, LAS unsigned char* lds) {
    const int tid = threadIdx.x, lane = tid & 63, wave = tid >> 6, G = gridDim.x;
    const int gw = blockIdx.x * 8 + wave, NGW = G * 8;
    const h16* of = (const h16*)(p.ws + OFF_ODIR); const h16* ob = of + (size_t)T * 1024;
    const h16* ug = (const h16*)(p.ws + OFF_U) + 5 * UBLK;
    h16* mix = (h16*)(p.ws + OFF_MIX);
    const f32x2 gn = *((const f32x2*)p.g_norm + lane);
    {
        const int w = __builtin_amdgcn_readfirstlane(wave), r = lane & 15, g = lane >> 4, jt = w >> 1, vh = w & 1;
        LAS float* F = (LAS float*)lds;
        for (int unit = blockIdx.x; unit < 1024; unit += G) {
            const int nb = unit >> 3, h = unit & 7, dd = nb < 64 ? 1 : 0, n = dd ? 127 - nb : nb, hd = dd * 8 + h;
            const size_t item = (size_t)hd * 128 + n;
            const unsigned char* qf = p.ws + OFF_PQ + item * REC_BYTES + 8192;
            const float* cumb = (const float*)(p.ws + OFF_CUMB) + item * 128;
            const unsigned char* sf = p.ws + OFF_SFIN + (size_t)hd * 8 * 8 * 512;
            h16x4 qa[8]; f32x4 bc[8]; h16x4 sb[8][4];
            h16x2 a[8], b[8]; h16x2 gv[8];
#pragma unroll
            for (int rr = 0; rr < 8; ++rr) { const size_t o = (size_t)(64 * nb + 8 * w + rr) * 1024 + h * 128 + 2 * lane;
                a[rr] = *(const h16x2*)(of + o); b[rr] = *(const h16x2*)(ob + o); gv[rr] = *(const h16x2*)(ug + o); }
#pragma unroll
            for (int wp = 0; wp < 8; ++wp) { qa[wp] = *(const h16x4*)(qf + ((size_t)(wp * 2 + (jt >> 1)) * 64 + lane) * 16 + (jt & 1) * 8); bc[wp] = *(const f32x4*)(cumb + 16 * wp + 4 * g);
#pragma unroll
                for (int v4 = 0; v4 < 4; ++v4) sb[wp][v4] = *(const h16x4*)(sf + ((size_t)(wp * 8 + 4 * vh + v4) * 64 + lane) * 8); }
            f32x4 acc[4];
#pragma unroll
            for (int v4 = 0; v4 < 4; ++v4) acc[v4] = (f32x4){0.f, 0.f, 0.f, 0.f};
#pragma unroll
            for (int wp = 0; wp < 8; ++wp) { h16x4 a;
#pragma unroll
                for (int i = 0; i < 4; ++i) a[i] = (h16)((float)qa[wp][i] * __expf(bc[wp][i]));
#pragma unroll
                for (int v4 = 0; v4 < 4; ++v4) acc[v4] = __builtin_amdgcn_mfma_f32_16x16x16f16(a, sb[wp][v4], acc[v4], 0, 0, 0); }
#pragma unroll
            for (int v4 = 0; v4 < 4; ++v4)
#pragma unroll
                for (int i = 0; i < 4; ++i) { const int j = 16 * jt + 4 * g + i, rho = dd ? 63 - j : j; F[rho * 132 + 16 * (4 * vh + v4) + r] = acc[v4][i]; }
            LBAR();
            f32x2 fx[8];
#pragma unroll
            for (int rr = 0; rr < 8; ++rr) fx[rr] = *(const LAS f32x2*)(F + (8 * w + rr) * 132 + 2 * lane);
#pragma unroll
            for (int rr = 0; rr < 8; ++rr) { const int t = 64 * nb + 8 * w + rr; const float o0 = (float)a[rr].x + (float)b[rr].x + fx[rr].x, o1 = (float)a[rr].y + (float)b[rr].y + fx[rr].y;
                const float ss = wave_sum(o0 * o0 + o1 * o1); const float rs = __builtin_amdgcn_rsqf(ss * (1.f / 128.f) + RMS_EPS);
                *(unsigned*)(mix + (size_t)t * D + h * 128 + 2 * lane) = pko(o0 * rs * gn.x * (float)gv[rr].x, o1 * rs * gn.y * (float)gv[rr].y); }
            LBAR();
        }
    }
    LAS float* scr = (LAS float*)(lds + wave * 8448);
    constexpr int I_G = (D / 64) * (FF / 32);
    for (int it = gw; it < 2 * I_G; it += NGW) {
        if (it < I_G) transpose_item(p.w_gate, D, FF, (h16*)p.out, scr, it, lane, RmGate());
        else transpose_item(p.w_up, D, FF, (h16*)p.out, scr, it - I_G, lane, RmUp());
    }
}
__device__ __forceinline__ void wdown_transposes(const Params& p, LAS unsigned char* lds, int first_wg, int nwg) {
    const int tid = threadIdx.x, lane = tid & 63, wave = tid >> 6;
    const int gw = ((int)blockIdx.x - first_wg) * 8 + wave, NGW = nwg * 8;
    LAS float* scr = (LAS float*)(lds + wave * 8448);
    constexpr int I_D = (FF / 64) * (D / 32);
    for (int it = gw; it < I_D; it += NGW) transpose_item(p.w_down, FF, D, (h16*)(p.ws + OFF_WD), scr, it, lane, RmId());
}

#define XB_TMO      128
#define XB_XCNT(j)  (256  + 64 * (j))
#define XB_XSUB(j)  (1280 + 64 * (j))
#define XB_XGEN(j)  (2304 + 64 * (j))
#define XB_TOP      3328
#define XB_TOPGEN   3392
#define XCD_BAR_WORDS 3456
#define XB_SPIN_CAP (1u << 22)
__device__ __forceinline__ unsigned xb_ld(unsigned* p)              { return __hip_atomic_load(p, __ATOMIC_RELAXED, __HIP_MEMORY_SCOPE_AGENT); }
__device__ __forceinline__ unsigned xb_add(unsigned* p, unsigned v) { return __hip_atomic_fetch_add(p, v, __ATOMIC_RELAXED, __HIP_MEMORY_SCOPE_AGENT); }
__device__ __forceinline__ unsigned xb_xcc_id() { return (unsigned)__builtin_amdgcn_s_getreg((3 << 11) | 20) & 0xFu; }
#define XB_SPIN(cond, bar) do { unsigned _sp = 0; while (cond) { __builtin_amdgcn_s_sleep(1); \
    if ((++_sp & 255u) == 0u) { if (xb_ld(&(bar)[XB_TMO])) break; if (_sp > XB_SPIN_CAP) { atomicAdd(&(bar)[XB_TMO], 1u); break; } } } } while (0)
__device__ __forceinline__ void xcd_barrier(unsigned* bar, unsigned x, volatile LAS unsigned* st) {
    asm volatile("s_waitcnt vmcnt(0) lgkmcnt(0)" ::: "memory");
    __builtin_amdgcn_s_barrier();
    if (threadIdx.x == 0) {
        unsigned nloc = st[0], nx = st[1];
        if (nloc == 0u) {
            const unsigned G = gridDim.x; unsigned sum, cnt, mine, sp = 0u;
            for (;;) { sum = 0u; cnt = 0u; mine = 0u;
#pragma unroll
                for (unsigned j = 0; j < 16; ++j) { const unsigned c = xb_ld(&bar[XB_XCNT(j)]); sum += c; cnt += (c > 0u) ? 1u : 0u; mine = (j == x) ? c : mine; }
                if (sum == G) break;
                __builtin_amdgcn_s_sleep(1);
                if ((++sp & 255u) == 0u) { if (xb_ld(&bar[XB_TMO])) break; if (sp > XB_SPIN_CAP) { atomicAdd(&bar[XB_TMO], 1u); break; } } }
            nloc = mine > 0u ? mine : 1u; nx = cnt > 0u ? cnt : 1u; st[0] = nloc; st[1] = nx; }
        const unsigned old = xb_add(&bar[XB_XSUB(x)], 1u);
        const unsigned gen = old / nloc;
        if (old + 1u == (gen + 1u) * nloc) {
            __builtin_amdgcn_fence(__ATOMIC_RELEASE, "agent");
            asm volatile("s_waitcnt vmcnt(0)" ::: "memory");
            const unsigned og = xb_add(&bar[XB_TOP], 1u);
            const unsigned tg = og / nx;
            if (og + 1u == (tg + 1u) * nx) xb_add(&bar[XB_TOPGEN], 1u);
            else XB_SPIN(xb_ld(&bar[XB_TOPGEN]) == tg, bar);
            __builtin_amdgcn_fence(__ATOMIC_ACQUIRE, "agent");
            xb_add(&bar[XB_XGEN(x)], 1u);
            asm volatile("s_waitcnt vmcnt(0)" ::: "memory");
        } else {
            XB_SPIN(xb_ld(&bar[XB_XGEN(x)]) == gen, bar);
            __builtin_amdgcn_fence(__ATOMIC_ACQUIRE, "agent");
            asm volatile("s_waitcnt vmcnt(0)" ::: "memory");
        }
    }
    asm volatile("s_waitcnt lgkmcnt(0)" ::: "memory");
    __builtin_amdgcn_s_barrier();
    asm volatile("" ::: "memory");
}

__global__ void __launch_bounds__(512, 2) fwd_megakernel(Params p) {
    extern __shared__ __attribute__((aligned(16))) unsigned char shm[];
    LAS unsigned char* lds = (LAS unsigned char*)shm;
    const int G = gridDim.x, bid = blockIdx.x, tid = threadIdx.x, lane = tid & 63, wave = tid >> 6;
    const int gw = bid * 8 + wave, NGW = G * 8;
#ifndef PROBE_MASK
#define PROBE_MASK 0
#endif
#define RUN(ph) if (p.ph_lo <= (ph) && (ph) < p.ph_hi)
#define TSWB(i, b) do { if (TS_SEL && bid == (b) && tid == 0) ((unsigned long long*)(p.ws + OFF_TAB + 600 * 1024))[i] = __builtin_amdgcn_s_memrealtime(); } while (0)
#define TSW(i) do { if (TS_SEL && bid == 0 && tid == 0) ((unsigned long long*)(p.ws + OFF_TAB + 600 * 1024))[i] = __builtin_amdgcn_s_memrealtime(); } while (0)
    unsigned* const xbar = (unsigned*)(p.ws + OFF_BAR);
    const unsigned xcc = xb_xcc_id();
    volatile LAS unsigned* const xst = (volatile LAS unsigned*)(lds + 131072);
    if (p.ph_hi - p.ph_lo > 1) { if (tid == 0) { xst[0] = 0u; xst[1] = 0u; (void)xb_add(&xbar[XB_XCNT(xcc)], 1u); } LBAR(); }
    if (p.ph_hi > 1000) cg::this_grid().sync();
#define SYNC(ph) do { if (p.ph_lo < (ph) && (ph) < p.ph_hi) { xcd_barrier(xbar, xcc, xst); TSW(ph); } } while (0)
    TSW(0);
    RUN(0) phase0(p, lds);
    SYNC(1);
    RUN(1) { pg8::Gemm g{(const h16*)(p.ws + OFF_H0), (const h16*)(p.ws + OFF_WIN), T, PW, D}; pg8::StaticOrder S; S.init(T, PW, G, bid);
        pg8::EpiU E{(h16*)(p.ws + OFF_U)}; pg8::gemm_phase(lds, g, S, E); }
    SYNC(2);
    RUN(2) {
        for (int tile = bid; tile < 256; tile += G) fa_tile(p, lds, tile);
        TSWB(12, 0);
        for (int pr = bid; pr < 1024; pr += G) { const int nb = pr & 127, h = pr >> 7;
            prep_item(p, lds, (0 * 8 + h) * 128 + nb); prep_item(p, lds, (1 * 8 + h) * 128 + 127 - nb); }
    }
    SYNC(3);
    RUN(3) {
        for (int job = bid; job < 256; job += G) scan_job(p, lds, job);
        TSWB(10, 0);
        {
            const int r = lane & 15, g = lane >> 4;
            const h16* G64 = (const h16*)(p.ws + OFF_TAB) + 512 * 256 + 256 * 256;
            h16x8 Bg[4][4];
#pragma unroll
            for (int nt = 0; nt < 4; ++nt)
#pragma unroll
                for (int ks = 0; ks < 4; ++ks) Bg[nt][ks] = *(const h16x8*)(G64 + (16 * nt + r) * 128 + 32 * ks + 8 * g);
            unsigned* fctr = (unsigned*)(p.ws + OFF_CNT) + 4096 + 16;
            LAS unsigned* slot = (LAS unsigned*)(lds + 131072 + 8);
            int tile = bid;
            while (tile < 512) {
                unsigned claimed = 0u;
                if (tid == 0) claimed = (unsigned)G + __hip_atomic_fetch_add(fctr, 1u, __ATOMIC_RELAXED, __HIP_MEMORY_SCOPE_AGENT);
                fb_tile(p, lds, tile, Bg);
                if (tid == 0) *slot = claimed;
                LBAR();
                tile = (int)*slot;
            }
            TSWB(11, 255);
        }
    }
    SYNC(4);
    RUN(4) phase4(p, lds);
    SYNC(5);
    RUN(5) { pg8::Gemm g{(const h16*)(p.ws + OFF_MIX), (const h16*)(p.ws + OFF_WOUT), T, D, D}; pg8::StaticOrder S; S.init(T, D, G, bid);
        pg8::EpiLn<false> E{(const h16*)(p.ws + OFF_H0), (void*)(p.ws + OFF_H0), p.ln1_g, p.ln1_b, (float*)(p.ws + OFF_XB5), (unsigned*)(p.ws + OFF_CNT)}; pg8::gemm_phase(lds, g, S, E); }
    SYNC(7);
    RUN(7) { pg8::Gemm g{(const h16*)(p.ws + OFF_H0), (const h16*)p.out, T, 2 * FF, D}; pg8::StaticOrder S; S.init(T, 2 * FF, G, bid);
        pg8::EpiGlu E{(h16*)(p.ws + OFF_ACT)}; pg8::gemm_phase(lds, g, S, E);
        constexpr int NU = (T / 256) * (2 * FF / 256);
        const int busy = NU % G;
        if (busy == 0) wdown_transposes(p, lds, 0, G); else if (bid >= busy) wdown_transposes(p, lds, busy, G - busy); }
    SYNC(8);
    RUN(8) { pg8::Gemm g{(const h16*)(p.ws + OFF_ACT), (const h16*)(p.ws + OFF_WD), T, D, FF}; pg8::StaticOrder S; S.init(T, D, G, bid);
        pg8::EpiLn<true> E{(const h16*)(p.ws + OFF_H0), (void*)p.out, p.ln2_g, p.ln2_b, (float*)(p.ws + OFF_XB8), (unsigned*)(p.ws + OFF_CNT) + 2048}; pg8::gemm_phase(lds, g, S, E); }
}

extern "C" void kernel_launch(void* const* d_in, const int* in_sizes, int n_in, void* d_out, int out_size, void* d_ws, size_t ws_size, hipStream_t stream) {
    static int grid = 0;
    if (grid == 0) {
        if (n_in != 15 || in_sizes[0] != T * D || out_size != T * D || ws_size < WS_NEED) { fprintf(stderr, "kernel_launch: unexpected shapes (n_in %d in0 %d out %d ws %zu)\n", n_in, n_in > 0 ? in_sizes[0] : -1, out_size, ws_size); grid = -1; return; }
        int dev = 0, cus = 0, per_cu = 0;
        hipGetDevice(&dev); hipDeviceGetAttribute(&cus, hipDeviceAttributeMultiprocessorCount, dev);
        if (hipFuncSetAttribute((const void*)fwd_megakernel, hipFuncAttributeMaxDynamicSharedMemorySize, LDS_BYTES) != hipSuccess) { fprintf(stderr, "kernel_launch: hipFuncSetAttribute failed\n"); grid = -1; return; }
        if (hipOccupancyMaxActiveBlocksPerMultiprocessor(&per_cu, (const void*)fwd_megakernel, 512, LDS_BYTES) != hipSuccess || per_cu < 1) { fprintf(stderr, "kernel_launch: occupancy query gave %d\n", per_cu); per_cu = 1; }
        (void)hipGetLastError();
        grid = cus * 1;
        if (grid > 256) grid = 256;
        if (grid != 256) { fprintf(stderr, "kernel_launch: the fused LayerNorm epilogues need exactly 256 workgroups (one per CU); device has %d CUs\n", cus); grid = -1; return; }
    }
    if (grid < 0) return;
    Params p{};
    p.x = (const float*)d_in[0]; p.ln_emb_g = (const float*)d_in[1]; p.ln_emb_b = (const float*)d_in[2]; p.w_in = (const float*)d_in[3];
    p.lbf = (const float*)d_in[4]; p.lbb = (const float*)d_in[5]; p.g_norm = (const float*)d_in[6]; p.w_out = (const float*)d_in[7];
    p.ln1_g = (const float*)d_in[8]; p.ln1_b = (const float*)d_in[9]; p.w_gate = (const float*)d_in[10]; p.w_up = (const float*)d_in[11];
    p.w_down = (const float*)d_in[12]; p.ln2_g = (const float*)d_in[13]; p.ln2_b = (const float*)d_in[14];
    p.out = (float*)d_out; p.ws = (unsigned char*)d_ws;
#if N_LAUNCH_MODE == 1
    if (hipMemsetAsync((unsigned char*)d_ws + OFF_BAR, 0, XCD_BAR_WORDS * 4, stream) != hipSuccess) { fprintf(stderr, "kernel_launch: hipMemsetAsync failed\n"); return; }
    p.ph_lo = 0; p.ph_hi = 10;
    void* args[] = {&p};
    hipError_t e = hipLaunchCooperativeKernel((const void*)fwd_megakernel, dim3(grid), dim3(512), args, LDS_BYTES, stream);
    if (e != hipSuccess) fprintf(stderr, "cooperative launch failed: %s (grid %d)\n", hipGetErrorString(e), grid);
#else
    for (int ph = 0; ph < 10; ++ph) for (int rp = 0; rp < 1 + ((PROBE_MASK >> ph) & 1); ++rp) { p.ph_lo = ph; p.ph_hi = ph + 1; hipLaunchKernelGGL(fwd_megakernel, dim3(grid), dim3(512), LDS_BYTES, stream, p); }
#endif
}
```
